# Optimizing an MI355X kernel written in HIP

```python
import jax, jax.numpy as jnp
from jax import lax
import numpy as np

D_MODEL = 1024
BATCH = 32
SEQ = 2048
DEPTH = 1

D_MIX = D_MODEL
D_RET = D_MIX // 2
D_GLA = D_MIX - D_RET
RET_HEADS = 4
RET_DK = D_RET // RET_HEADS
RET_DV = D_RET // RET_HEADS
RET_CHUNK = 128
GLA_HEADS = 4
GLA_DK_TOTAL = D_GLA // 2
GLA_DK = GLA_DK_TOTAL // GLA_HEADS
GLA_DV = D_GLA // GLA_HEADS
GLA_CHUNK = 64
GLA_GATE_RANK = 16
GLA_GATE_TAU = 16.0
ROPE_THETA = 10000.0
EPS = 1e-6
D_IN = 4 * D_RET + 2 * GLA_DK_TOTAL + 2 * D_GLA + GLA_GATE_RANK

kernel_name = "hybrid_retention_gla_adaln_layer"


def _rms(x):
    xf = x.astype(jnp.float32)
    return (xf * lax.rsqrt(jnp.mean(xf * xf, axis=-1, keepdims=True) + EPS)).astype(x.dtype)


def _rotary(t):
    S, d = t.shape[1], t.shape[-1]
    inv_freq = ROPE_THETA ** (-jnp.arange(0, d, 2, dtype=jnp.float32) / d)
    ang = jnp.arange(S, dtype=jnp.float32)[:, None] * inv_freq[None, :]
    cos = jnp.cos(ang)[None, :, None, :]
    sin = jnp.sin(ang)[None, :, None, :]
    t1, t2 = jnp.split(t.astype(jnp.float32), 2, axis=-1)
    return jnp.concatenate([t1 * cos - t2 * sin, t1 * sin + t2 * cos], axis=-1).astype(t.dtype)


def _retention(q, k, v):
    B, S, H, dk = q.shape
    dv = v.shape[-1]
    C = RET_CHUNK
    nc = S // C
    log_g = jnp.log(1.0 - 2.0 ** (-5.0 - jnp.arange(H, dtype=jnp.float32)))
    q = q.reshape(B, nc, C, H, dk)
    k = k.reshape(B, nc, C, H, dk)
    v = v.reshape(B, nc, C, H, dv)
    idx = jnp.arange(C, dtype=jnp.float32)
    diff = idx[:, None] - idx[None, :]
    decay = jnp.where(diff[None] >= 0,
                      jnp.exp(jnp.maximum(diff, 0.0)[None] * log_g[:, None, None]), 0.0)
    scores = jnp.einsum('bnihd,bnjhd->bnhij', q, k) * decay
    inner = jnp.einsum('bnhij,bnjhe->bnihe', scores, v)
    zeta = jnp.exp((C - 1.0 - idx)[None, :] * log_g[:, None])
    kv = jnp.einsum('bnjhd,hj,bnjhe->nbhde', k, zeta, v)
    chunk_decay = jnp.exp(C * log_g)[None, :, None, None]

    def step(R, kv_n):
        return R * chunk_decay + kv_n, R

    _, R_prev = lax.scan(step, jnp.zeros((B, H, dk, dv), kv.dtype), kv)
    xi = jnp.exp((idx + 1.0)[None, :] * log_g[:, None])
    cross = jnp.einsum('bnihd,nbhde,hi->bnihe', q, R_prev, xi)
    return (inner + cross).reshape(B, S, H, dv)


def _gla(q, k, v, log_a):
    B, S, H, dk = q.shape
    dv = v.shape[-1]
    C = GLA_CHUNK
    nc = S // C
    q = q.reshape(B, nc, C, H, dk).astype(jnp.float32)
    k = k.reshape(B, nc, C, H, dk).astype(jnp.float32)
    v = v.reshape(B, nc, C, H, dv)
    b = jnp.cumsum(log_a.reshape(B, nc, C, H, dk).astype(jnp.float32), axis=2)
    q_e = q * jnp.exp(b)
    k_e = k * jnp.exp(-b)
    mask = jnp.tril(jnp.ones((C, C), dtype=bool))
    scores = jnp.where(mask, jnp.einsum('bnihd,bnjhd->bnhij', q_e, k_e), 0.0)
    inner = jnp.einsum('bnhij,bnjhe->bnihe', scores, v)
    b_last = b[:, :, -1:]
    kv = jnp.einsum('bnjhd,bnjhe->nbhde', k * jnp.exp(b_last - b), v)
    a_chunk = jnp.transpose(jnp.exp(b_last[:, :, 0]), (1, 0, 2, 3))

    def step(St, inp):
        kv_n, a_n = inp
        return St * a_n[..., None] + kv_n, St

    _, S_prev = lax.scan(step, jnp.zeros((B, H, dk, dv), kv.dtype), (kv, a_chunk))
    cross = jnp.einsum('bnihd,nbhde->bnihe', q_e, S_prev)
    return (inner + cross).reshape(B, S, H, dv)


def setup_inputs(seed: int = 0) -> dict:
    key = jax.random.key(seed)
    ks = jax.random.split(key, 12)
    f32 = jnp.float32
    x = jax.random.normal(ks[0], (BATCH, SEQ, D_MODEL), f32)
    c = jax.random.normal(ks[1], (BATCH, D_MODEL), f32)
    norm_gain = 1.0 + 0.02 * jax.random.normal(ks[2], (DEPTH, D_MODEL), f32)
    w_ada = jax.random.normal(ks[3], (DEPTH, D_MODEL, 3 * D_MODEL), f32) * D_MODEL ** -0.5
    b_ada = 0.02 * jax.random.normal(ks[4], (DEPTH, 3 * D_MODEL), f32)
    w_in = jax.random.normal(ks[5], (DEPTH, D_MODEL, D_IN), f32) * D_MODEL ** -0.5
    w_gate_up = jax.random.normal(ks[6], (DEPTH, GLA_GATE_RANK, GLA_DK_TOTAL), f32) * GLA_GATE_RANK ** -0.5
    b_gate_up = 0.02 * jax.random.normal(ks[7], (DEPTH, GLA_DK_TOTAL), f32)
    gla_norm_gain = 1.0 + 0.02 * jax.random.normal(ks[8], (DEPTH, GLA_DV), f32)
    w_out = jax.random.normal(ks[9], (DEPTH, D_MIX, D_MODEL), f32) * D_MIX ** -0.5
    final_gain = 1.0 + 0.02 * jax.random.normal(ks[10], (D_MODEL,), f32)
    return {"x": x, "c": c, "norm_gain": norm_gain, "w_ada": w_ada, "b_ada": b_ada,
            "w_in": w_in, "w_gate_up": w_gate_up, "b_gate_up": b_gate_up,
            "gla_norm_gain": gla_norm_gain, "w_out": w_out, "final_gain": final_gain}


def reference(x, c, norm_gain, w_ada, b_ada, w_in, w_gate_up, b_gate_up, gla_norm_gain, w_out, final_gain):
    B, S, D = x.shape
    cs = jax.nn.silu(c)
    for l in range(DEPTH):
        ada = cs @ w_ada[l] + b_ada[l]
        shift, scale, gate = jnp.split(ada, 3, axis=-1)
        h = _rms(x) * norm_gain[l] * (1.0 + scale[:, None, :]) + shift[:, None, :]
        p = h @ w_in[l]
        o = np.cumsum([0, D_RET, D_RET, D_RET, D_RET, GLA_DK_TOTAL, GLA_DK_TOTAL, D_GLA, D_GLA, GLA_GATE_RANK])
        rq, rk, rv, rz, gq, gk, gv, gz, glr = [p[..., o[i]:o[i + 1]] for i in range(9)]
        rq = _rotary(rq.reshape(B, S, RET_HEADS, RET_DK))
        rk = _rotary(rk.reshape(B, S, RET_HEADS, RET_DK)) * (RET_DK ** -0.5)
        y_ret = _retention(rq, rk, rv.reshape(B, S, RET_HEADS, RET_DV))
        y_ret = _rms(y_ret) * jax.nn.silu(rz.reshape(B, S, RET_HEADS, RET_DV).astype(jnp.float32))
        log_a = jax.nn.log_sigmoid((glr @ w_gate_up[l] + b_gate_up[l]).astype(jnp.float32)) / GLA_GATE_TAU
        y_gla = _gla(gq.reshape(B, S, GLA_HEADS, GLA_DK) * (GLA_DK ** -0.5),
                     gk.reshape(B, S, GLA_HEADS, GLA_DK),
                     gv.reshape(B, S, GLA_HEADS, GLA_DV),
                     log_a.reshape(B, S, GLA_HEADS, GLA_DK))
        y_gla = _rms(y_gla) * gla_norm_gain[l] * jax.nn.silu(gz.reshape(B, S, GLA_HEADS, GLA_DV).astype(jnp.float32))
        mix = jnp.concatenate([y_ret.reshape(B, S, D_RET), y_gla.reshape(B, S, D_GLA)], axis=-1).astype(x.dtype)
        x = x + gate[:, None, :] * (mix @ w_out[l])
    return _rms(x) * final_gain
```

```cpp
#include <hip/hip_runtime.h>
#include <hip/hip_cooperative_groups.h>
#include <cstdio>
#include <cstdint>
namespace cg = cooperative_groups;
namespace pg8 {
#define PG8_LAS __attribute__((address_space(3)))
typedef unsigned short bf16_t;
typedef short bf16x8 __attribute__((ext_vector_type(8)));
typedef float f32x4 __attribute__((ext_vector_type(4)));
typedef unsigned u32x4 __attribute__((ext_vector_type(4)));
constexpr int BM = 256, BK = 64, HALF = 128, HTB = HALF * BK * 2  , STAGE_BYTES = 8 * HTB, NXCD = 8, WGM = 8;

__host__ __device__ __forceinline__ int lds_byte(int r, int c) { const int st = (r >> 4) * 2 + (c >> 5), rr = r & 15, cc = c & 31, ob = rr * 64 + cc * 2; return st * 1024 + (ob ^ (((ob >> 9) & 1) << 5)); }
__host__ __device__ __forceinline__ void stage_rc(int b, int& R, int& C) { const int st = b / 1024, sb = b % 1024, swz = sb ^ (((sb >> 9) & 1) << 5); R = (st >> 1) * 16 + swz / 64; C = (st & 1) * 32 + (swz % 64) / 2; }
__host__ __device__ __forceinline__ int perm32(int rho) { const int n = rho >> 4, i = rho & 15; return 8 * (i >> 2) + 4 * n + (i & 3); }

struct Unit { int pm, pn; };
struct Gemm { const bf16_t* A; const bf16_t* Bt; int M, N, K; };

struct StaticOrder {
    int nM, nN, nwg, G, c;
    __host__ __device__ void init(int M, int N, int G_, int c_) { nM = M / BM; nN = N / BM; nwg = nM * nN; G = G_; c = c_; }
    __host__ __device__ bool next(int i, Unit& u) const {
        const long L = (long)i * G + c; if (L >= nwg) return false;
        int wgid = (int)L; { const int q = nwg / NXCD, r = nwg % NXCD, xcd = wgid % NXCD, off = wgid / NXCD; wgid = (xcd < r ? xcd * (q + 1) : r * (q + 1) + (xcd - r) * q) + off; }
        const int nig = WGM * nN, gid = wgid / nig, fm = gid * WGM, gsz = (nM - fm) < WGM ? (nM - fm) : WGM;
        u.pm = fm + ((wgid % nig) % gsz); u.pn = (wgid % nig) / gsz; return true;
    }
    __device__ __forceinline__ void a_ready(const Unit&) const {}
    __device__ __forceinline__ void done(const Unit&) const {}
};

__device__ __forceinline__ unsigned cvt_pk_bf16(float lo, float hi) { unsigned r; asm volatile("v_cvt_pk_bf16_f32 %0, %1, %2" : "=v"(r) : "v"(lo), "v"(hi)); return r; }
typedef float f32x2 __attribute__((ext_vector_type(2)));
__device__ __forceinline__ f32x2 gelu_pk(f32x2 v) {
    const f32x2 av = __builtin_elementwise_abs(v), d = av * 0.2316418882f + 1.0f;
    f32x2 t; t.x = __builtin_amdgcn_rcpf(d.x); t.y = __builtin_amdgcn_rcpf(d.y);
    f32x2 q = t * 0.5307027145f + (-0.7265760135f); q = q * t + 0.7107068705f; q = q * t + (-0.142248368f); q = q * t + 0.127414796f; q = q * t;
    const f32x2 s = (v * v) * (-0.72134752044f);
    f32x2 e; e.x = __builtin_amdgcn_exp2f(s.x); e.y = __builtin_amdgcn_exp2f(s.y);
    const f32x2 m = v * (q * e), r = v - m;
    f32x2 o; o.x = v.x < 0.f ? m.x : r.x; o.y = v.y < 0.f ? m.y : r.y; return o;
}

template <int ACT  > struct EpiBf16 {
    static constexpr bool PERM = true, AFTER_DRAIN = false; static_assert(ACT == 0 || ACT == 1, "EpiBf16: ACT is 0 (none) or 1 (gelu_pk)");
    bf16_t* O; int ldc; const float* bias; int split_cols; size_t split_stride; float scale0;
    __device__ __forceinline__ void operator()(const f32x4 (&acc)[2][2][4][2], const Unit& u, int wr, int wc, int fr, int fq) const {
        const int row0 = u.pm * BM + wr * 64 + fr; int colt = u.pn * BM; bf16_t* base = O;
        float sc = 1.f; if (split_cols) { const int t = colt / split_cols; base += (size_t)t * split_stride; colt -= t * split_cols; if (t == 0) sc = scale0; }
        const int col0 = colt + wc * 32 + 8 * fq, bcol0 = u.pn * BM + wc * 32 + 8 * fq;
        f32x4 bv[2][2];
#pragma unroll
        for (int bj = 0; bj < 2; ++bj)
#pragma unroll
            for (int n = 0; n < 2; ++n) bv[bj][n] = bias ? *(const f32x4*)(bias + bcol0 + bj * HALF + 4 * n) : (f32x4){0.f, 0.f, 0.f, 0.f};
#pragma unroll
        for (int ai = 0; ai < 2; ++ai)
#pragma unroll
            for (int m = 0; m < 4; ++m) { bf16_t* rowp = base + (size_t)(row0 + ai * HALF + m * 16) * ldc + col0;
#pragma unroll
                for (int bj = 0; bj < 2; ++bj) { f32x4 v0 = acc[ai][bj][m][0] + bv[bj][0], v1 = acc[ai][bj][m][1] + bv[bj][1];
                    if (ACT == 1) { f32x2 a = gelu_pk((f32x2){v0[0], v0[1]}), b = gelu_pk((f32x2){v0[2], v0[3]}), c = gelu_pk((f32x2){v1[0], v1[1]}), d = gelu_pk((f32x2){v1[2], v1[3]});
                        v0 = (f32x4){a.x, a.y, b.x, b.y}; v1 = (f32x4){c.x, c.y, d.x, d.y}; }
                    v0 = v0 * sc; v1 = v1 * sc; u32x4 w; w.x = cvt_pk_bf16(v0[0], v0[1]); w.y = cvt_pk_bf16(v0[2], v0[3]); w.z = cvt_pk_bf16(v1[0], v1[1]); w.w = cvt_pk_bf16(v1[2], v1[3]);
                    *(u32x4*)(rowp + bj * HALF) = w; } }
    }
};
template <class Epi, class Sched, bool ALIGN_EPI = false, bool SP2 = false>
__device__ __forceinline__ void gemm_phase(PG8_LAS unsigned char* lds, const Gemm g, const Sched& S, const Epi& E) {
    const int tid = threadIdx.x, wid = __builtin_amdgcn_readfirstlane(tid >> 6), lane = tid & 63, wr = wid >> 2, wc = wid & 3, fr = lane & 15, fq = lane >> 4;
    const int K = g.K, nt = K / BK;
    unsigned voffA[2], voffB[2];
#pragma unroll
    for (int i = 0; i < 2; ++i) { int R, C; stage_rc(tid * 16 + i * 8192, R, C); const int Rb = Epi::PERM ? ((R & ~31) + perm32(R & 31)) : R;
        voffA[i] = (unsigned)(R * K + C) * 2u; voffB[i] = (unsigned)(Rb * K + C) * 2u; }
    const size_t kstep = (size_t)(BK * 2);
    const size_t hstep = (size_t)HALF * K * 2;
    const size_t tstep = 2 * hstep;
    const unsigned ldsw = (unsigned)wid * 1024u;
    const int aoff = lds_byte(wr * 64 + fr, fq * 8), boff = lds_byte(wc * 32 + fr, fq * 8);
#define PG8_SA(b, h) (((b) * 2 + (h)) * HTB)
#define PG8_SB(b, h) ((4 + (b) * 2 + (h)) * HTB)
#define PG8_STAGE(bufoff, gbase, voff) do { _Pragma("unroll") for (int _i = 0; _i < 2; ++_i) \
        __builtin_amdgcn_global_load_lds((const unsigned*)((const char*)(gbase) + (voff)[_i]), (PG8_LAS unsigned*)(lds + (bufoff) + ldsw + _i * 8192), 16, 0, 0); } while (0)
#define PG8_LDA(dst, b, h) do { _Pragma("unroll") for (int m = 0; m < 4; ++m) _Pragma("unroll") for (int k = 0; k < 2; ++k) dst[m][k] = *(const PG8_LAS bf16x8*)(lds + PG8_SA(b, h) + aoff + m * 2048 + k * 1024); } while (0)
#define PG8_LDB(dst, b, h) do { _Pragma("unroll") for (int n = 0; n < 2; ++n) _Pragma("unroll") for (int k = 0; k < 2; ++k) dst[n][k] = *(const PG8_LAS bf16x8*)(lds + PG8_SB(b, h) + boff + n * 2048 + k * 1024); } while (0)
#define PG8_MMA(ai, bj, At, Bt) do { __builtin_amdgcn_s_setprio(1); _Pragma("unroll") for (int m = 0; m < 4; ++m) _Pragma("unroll") for (int n = 0; n < 2; ++n) _Pragma("unroll") for (int k = 0; k < 2; ++k) \
        acc[ai][bj][m][n] = __builtin_amdgcn_mfma_f32_16x16x32_bf16(Bt[n][k], At[m][k], acc[ai][bj][m][n], 0, 0, 0); __builtin_amdgcn_s_setprio(0); } while (0)
#define PG8_WAIT_V(n) asm volatile("s_waitcnt vmcnt(" #n ")" ::: "memory")
#define PG8_WAIT_L(n) asm volatile("s_waitcnt lgkmcnt(" #n ")" ::: "memory")
#define PG8_BAR __builtin_amdgcn_s_barrier()
#define PG8_SCHED __builtin_amdgcn_sched_barrier(0)
    Unit cur, nxt; int ui = 0;
    if (!S.next(0, cur)) return;
    f32x4 acc[2][2][4][2];
#pragma unroll
    for (int a = 0; a < 2; ++a)
#pragma unroll
        for (int b = 0; b < 2; ++b)
#pragma unroll
            for (int m = 0; m < 4; ++m)
#pragma unroll
                for (int n = 0; n < 2; ++n) acc[a][b][m][n] = (f32x4){0.f, 0.f, 0.f, 0.f};
    bf16x8 At[4][2], B0[2][2], B1[2][2];
    const char* cA = (const char*)g.A + (size_t)cur.pm * tstep; const char* cB = (const char*)g.Bt + (size_t)cur.pn * tstep;
    S.a_ready(cur);
    if constexpr (SP2) {
        PG8_STAGE(PG8_SB(0, 0), cB, voffB); PG8_STAGE(PG8_SB(0, 1), cB + hstep, voffB); PG8_STAGE(PG8_SA(0, 0), cA, voffA); PG8_STAGE(PG8_SA(0, 1), cA + hstep, voffA);
        if (wr == 1) PG8_BAR;
        PG8_WAIT_V(2); PG8_BAR;
        PG8_STAGE(PG8_SB(1, 0), cB + kstep, voffB); PG8_STAGE(PG8_SA(1, 0), cA + kstep, voffA); PG8_STAGE(PG8_SB(1, 1), cB + hstep + kstep, voffB);
        PG8_WAIT_V(6); PG8_BAR;
    } else {
        PG8_STAGE(PG8_SB(0, 0), cB, voffB); PG8_STAGE(PG8_SA(0, 0), cA, voffA); PG8_STAGE(PG8_SB(0, 1), cB + hstep, voffB); PG8_STAGE(PG8_SA(0, 1), cA + hstep, voffA);
        if (wr == 1) PG8_BAR;
        PG8_WAIT_V(4); PG8_BAR;
        PG8_STAGE(PG8_SB(1, 0), cB + kstep, voffB); PG8_STAGE(PG8_SA(1, 0), cA + kstep, voffA); PG8_STAGE(PG8_SB(1, 1), cB + hstep + kstep, voffB);
        PG8_WAIT_V(6); PG8_BAR;
    }
    for (;;) {
        const bool has_next = S.next(ui + 1, nxt);
        const char* nA = has_next ? (const char*)g.A + (size_t)nxt.pm * tstep : cA; const char* nB = has_next ? (const char*)g.Bt + (size_t)nxt.pn * tstep : cB;
        for (int t = 0; t < nt; t += 2) {
            const bool last = (t == nt - 2);
            const char* a1 = cA + (size_t)(t + 1) * kstep;
            const char* a2 = last ? nA : cA + (size_t)(t + 2) * kstep; const char* b2 = last ? nB : cB + (size_t)(t + 2) * kstep;
            const char* a3 = a2 + kstep; const char* b3 = b2 + kstep;
            if (last && has_next) S.a_ready(nxt);
            if constexpr (SP2) {
            PG8_LDB(B0, 0, 0); PG8_LDB(B1, 0, 1); PG8_SCHED; PG8_LDA(At, 0, 0); PG8_STAGE(PG8_SA(1, 1), a1 + hstep, voffA);
            PG8_WAIT_V(8); PG8_WAIT_L(0); PG8_BAR; PG8_MMA(0, 0, At, B0); PG8_MMA(0, 1, At, B1); PG8_BAR; PG8_SCHED;
            PG8_LDA(At, 0, 1); PG8_STAGE(PG8_SB(0, 0), b2, voffB); PG8_STAGE(PG8_SB(0, 1), b2 + hstep, voffB); PG8_STAGE(PG8_SA(0, 0), a2, voffA);
            PG8_WAIT_V(8); PG8_WAIT_L(0); PG8_BAR; PG8_MMA(1, 0, At, B0); PG8_MMA(1, 1, At, B1); PG8_BAR; PG8_SCHED;
            PG8_LDB(B0, 1, 0); PG8_LDB(B1, 1, 1); PG8_SCHED; PG8_LDA(At, 1, 0); PG8_STAGE(PG8_SA(0, 1), a2 + hstep, voffA);
            PG8_WAIT_V(8); PG8_WAIT_L(0); PG8_BAR; PG8_MMA(0, 0, At, B0); PG8_MMA(0, 1, At, B1); PG8_BAR; PG8_SCHED;
            PG8_LDA(At, 1, 1); PG8_STAGE(PG8_SB(1, 0), b3, voffB); PG8_STAGE(PG8_SB(1, 1), b3 + hstep, voffB); PG8_STAGE(PG8_SA(1, 0), a3, voffA);
            PG8_WAIT_V(8); PG8_WAIT_L(0); PG8_BAR; PG8_MMA(1, 0, At, B0); PG8_MMA(1, 1, At, B1); PG8_BAR; PG8_SCHED;
            } else {
            PG8_LDB(B0, 0, 0); PG8_SCHED; PG8_LDA(At, 0, 0); PG8_STAGE(PG8_SA(1, 1), a1 + hstep, voffA);
            PG8_WAIT_L(8); PG8_BAR; PG8_WAIT_L(0); PG8_MMA(0, 0, At, B0); PG8_BAR; PG8_SCHED;
            PG8_LDB(B1, 0, 1); PG8_STAGE(PG8_SB(0, 0), b2, voffB);
            PG8_BAR; PG8_WAIT_L(0); PG8_MMA(0, 1, At, B1); PG8_BAR;
            PG8_LDA(At, 0, 1); PG8_STAGE(PG8_SA(0, 0), a2, voffA);
            PG8_BAR; PG8_WAIT_L(0); PG8_MMA(1, 0, At, B0); PG8_BAR; PG8_SCHED;
            PG8_STAGE(PG8_SB(0, 1), b2 + hstep, voffB);
            PG8_WAIT_V(6); PG8_BAR; PG8_MMA(1, 1, At, B1); PG8_BAR;
            PG8_LDB(B0, 1, 0); PG8_SCHED; PG8_LDA(At, 1, 0); PG8_STAGE(PG8_SA(0, 1), a2 + hstep, voffA);
            PG8_WAIT_L(8); PG8_BAR; PG8_WAIT_L(0); PG8_MMA(0, 0, At, B0); PG8_BAR; PG8_SCHED;
            PG8_LDB(B1, 1, 1); PG8_STAGE(PG8_SB(1, 0), b3, voffB);
            PG8_BAR; PG8_WAIT_L(0); PG8_MMA(0, 1, At, B1); PG8_BAR;
            PG8_LDA(At, 1, 1); PG8_STAGE(PG8_SA(1, 0), a3, voffA);
            PG8_BAR; PG8_WAIT_L(0); PG8_MMA(1, 0, At, B0); PG8_BAR; PG8_SCHED;
            PG8_STAGE(PG8_SB(1, 1), b3 + hstep, voffB);
            PG8_WAIT_V(6); PG8_BAR; PG8_MMA(1, 1, At, B1); PG8_BAR;
            }
        }
        if constexpr (ALIGN_EPI) { if (wr == 0) PG8_BAR; }
        if constexpr (!Epi::AFTER_DRAIN) { E(acc, cur, wr, wc, fr, fq); S.done(cur); }
        if (!has_next) break;
#pragma unroll
        for (int a = 0; a < 2; ++a)
#pragma unroll
            for (int b = 0; b < 2; ++b)
#pragma unroll
                for (int m = 0; m < 4; ++m)
#pragma unroll
                    for (int n = 0; n < 2; ++n) acc[a][b][m][n] = (f32x4){0.f, 0.f, 0.f, 0.f};
        cur = nxt; cA = nA; cB = nB; ++ui;
        if constexpr (ALIGN_EPI) { if (wr == 1) PG8_BAR; }
    }
    PG8_WAIT_V(0);
    if constexpr (!ALIGN_EPI) { if (wr == 0) PG8_BAR; }
    PG8_BAR;
    if constexpr (Epi::AFTER_DRAIN) { E.fused(acc, cur, wr, wc, fr, fq, lds, wid, lane); S.done(cur); }
#undef PG8_SA
#undef PG8_SB
#undef PG8_STAGE
#undef PG8_LDA
#undef PG8_LDB
#undef PG8_MMA
#undef PG8_WAIT_V
#undef PG8_WAIT_L
#undef PG8_BAR
#undef PG8_SCHED
}
}

constexpr int NB = 32, SEQ = 2048, DM = 1024, NT = NB * SEQ;
constexpr int DIN = 3600, NPAD = 3840, PW = 3584;
constexpr float EPS = 1e-6f;
constexpr size_t MiB = 1u << 20;
constexpr size_t WS_MUL = 1 * MiB, WS_SHIFT = WS_MUL + 131072, WS_GATE = WS_SHIFT + 131072;
constexpr size_t WS_WIN = 2 * MiB;
constexpr size_t WS_WOUT = 10 * MiB;
constexpr size_t WS_GLR = 12 * MiB;
constexpr size_t WS_H = 16 * MiB;
constexpr size_t WS_P = 144 * MiB;
constexpr size_t WS_MIX = 592 * MiB;
constexpr size_t WS_END = 720 * MiB;
constexpr int LDS_BYTES = 147456;

#define LAS __attribute__((address_space(3)))
typedef unsigned short bf16;
typedef float f32x4 __attribute__((ext_vector_type(4)));
typedef unsigned u32x4 __attribute__((ext_vector_type(4)));
typedef unsigned u32x2 __attribute__((ext_vector_type(2)));

__device__ __forceinline__ unsigned f2bf(float f) { unsigned u = __builtin_bit_cast(unsigned, f); return (u + 0x7fffu + ((u >> 16) & 1u)) >> 16; }
__device__ __forceinline__ unsigned pk2(float lo, float hi) { return f2bf(lo) | (f2bf(hi) << 16); }
__device__ __forceinline__ float bf2f(unsigned v) { return __builtin_bit_cast(float, v << 16); }
__device__ __forceinline__ float wave_sum(float v) {
#pragma unroll
    for (int o = 1; o < 64; o <<= 1) v += __shfl_xor(v, o);
    return v;
}
__device__ __forceinline__ float silu_f(float v) { return v / (1.f + __expf(-v)); }

struct EpiP {
    static constexpr bool PERM = true, AFTER_DRAIN = false;
    bf16* P; float* GLR;
    __device__ __forceinline__ void operator()(const pg8::f32x4 (&acc)[2][2][4][2], const pg8::Unit& u, int wr, int wc, int fr, int fq) const {
        const int pn = u.pn;
        const int row0 = u.pm * 256 + wr * 64 + fr;
        const int cl = wc * 32 + 8 * fq;
        if (pn < 4) {
            const float sc = (pn >= 2) ? 0.08838834764831845f : 1.0f;
            float frev[4];
#pragma unroll
            for (int j = 0; j < 4; ++j) frev[j] = exp2f(-(float)(16 * wc + 4 * fq + j) * 0.20762050593046014f) * 0.15915494309189535f;
#pragma unroll
            for (int ai = 0; ai < 2; ++ai)
#pragma unroll
                for (int m = 0; m < 4; ++m) {
                    const int row = row0 + ai * 128 + m * 16;
                    const float pos = (float)(row & (SEQ - 1));
                    float sn[4], cs[4];
#pragma unroll
                    for (int j = 0; j < 4; ++j) { const float rev = __builtin_amdgcn_fractf(pos * frev[j]); sn[j] = __builtin_amdgcn_sinf(rev) * sc; cs[j] = __builtin_amdgcn_cosf(rev) * sc; }
#pragma unroll
                    for (int bj = 0; bj < 2; ++bj) {
                        const pg8::f32x4 v0 = acc[ai][bj][m][0], v1 = acc[ai][bj][m][1];
                        u32x4 w;
                        w.x = pk2(v0[0] * cs[0] - v0[1] * sn[0], v0[0] * sn[0] + v0[1] * cs[0]);
                        w.y = pk2(v0[2] * cs[1] - v0[3] * sn[1], v0[2] * sn[1] + v0[3] * cs[1]);
                        w.z = pk2(v1[0] * cs[2] - v1[1] * sn[2], v1[0] * sn[2] + v1[1] * cs[2]);
                        w.w = pk2(v1[2] * cs[3] - v1[3] * sn[3], v1[2] * sn[3] + v1[3] * cs[3]);
                        *(u32x4*)(P + (size_t)row * PW + pn * 256 + bj * 128 + cl) = w;
                    }
                }
        } else if (pn < 14) {
            const bool act = (pn == 6 || pn == 7 || pn == 12 || pn == 13);
            const float sc = (pn == 8) ? 0.125f : 1.0f;
#pragma unroll
            for (int ai = 0; ai < 2; ++ai)
#pragma unroll
                for (int m = 0; m < 4; ++m) {
                    const int row = row0 + ai * 128 + m * 16;
#pragma unroll
                    for (int bj = 0; bj < 2; ++bj) {
                        pg8::f32x4 v0 = acc[ai][bj][m][0] * sc, v1 = acc[ai][bj][m][1] * sc;
                        if (act) {
#pragma unroll
                            for (int i = 0; i < 4; ++i) { v0[i] = silu_f(v0[i]); v1[i] = silu_f(v1[i]); }
                        }
                        u32x4 w; w.x = pk2(v0[0], v0[1]); w.y = pk2(v0[2], v0[3]); w.z = pk2(v1[0], v1[1]); w.w = pk2(v1[2], v1[3]);
                        *(u32x4*)(P + (size_t)row * PW + pn * 256 + bj * 128 + cl) = w;
                    }
                }
        } else {
            if (wc == 0 && fq < 2) {
#pragma unroll
                for (int ai = 0; ai < 2; ++ai)
#pragma unroll
                    for (int m = 0; m < 4; ++m) {
                        const int row = row0 + ai * 128 + m * 16;
                        *(pg8::f32x4*)(GLR + (size_t)row * 16 + 8 * fq) = acc[ai][0][m][0];
                        *(pg8::f32x4*)(GLR + (size_t)row * 16 + 8 * fq + 4) = acc[ai][0][m][1];
                    }
            }
        }
    }
};
struct EpiOut {
    static constexpr bool PERM = false, AFTER_DRAIN = false;
    const float* x; const float* gate; float* out;
    __device__ __forceinline__ void operator()(const pg8::f32x4 (&acc)[2][2][4][2], const pg8::Unit& u, int wr, int wc, int fr, int fq) const {
        const int row0 = u.pm * 256 + wr * 64 + fr, col0 = u.pn * 256 + wc * 32 + 4 * fq, b = u.pm >> 3;
        pg8::f32x4 g[2][2];
#pragma unroll
        for (int bj = 0; bj < 2; ++bj)
#pragma unroll
            for (int n = 0; n < 2; ++n) g[bj][n] = *(const pg8::f32x4*)(gate + b * DM + col0 + bj * 128 + n * 16);
#pragma unroll
        for (int ai = 0; ai < 2; ++ai)
#pragma unroll
            for (int m = 0; m < 4; ++m) {
                const size_t ro = (size_t)(row0 + ai * 128 + m * 16) * DM + col0;
#pragma unroll
                for (int bj = 0; bj < 2; ++bj)
#pragma unroll
                    for (int n = 0; n < 2; ++n) {
                        const size_t off = ro + bj * 128 + n * 16;
                        const pg8::f32x4 xv = *(const pg8::f32x4*)(x + off);
                        *(pg8::f32x4*)(out + off) = xv + g[bj][n] * acc[ai][bj][m][n];
                    }
            }
    }
};

__device__ __forceinline__ void phase_ada(LAS unsigned char* lds, const float* c, const float* w_ada, const float* b_ada, const float* norm_gain, float* MUL, float* SHIFT, float* GATE) {
    const int tid = threadIdx.x, lane = tid & 63, wave = tid >> 6;
    LAS float* sc = (LAS float*)lds;
    LAS float* red = (LAS float*)(lds + 131072);
    for (int i = tid; i < NB * DM; i += 512) sc[i] = silu_f(c[i]);
    __syncthreads();
    const int kg = tid >> 4, cs = tid & 15;
    for (int cb = blockIdx.x; cb < 256; cb += gridDim.x) {
        float acc[32];
#pragma unroll
        for (int b = 0; b < 32; ++b) acc[b] = 0.f;
        if (cs < 12) {
            const float* wp = w_ada + cb * 12 + cs;
            for (int k = kg; k < DM; k += 32) {
                const float w = wp[(size_t)k * 3072];
#pragma unroll
                for (int b = 0; b < 32; ++b) acc[b] += sc[b * 1024 + k] * w;
            }
        }
#pragma unroll
        for (int b = 0; b < 32; ++b) { acc[b] += __shfl_xor(acc[b], 16); acc[b] += __shfl_xor(acc[b], 32); }
        if (lane < 16) {
#pragma unroll
            for (int b = 0; b < 32; ++b) red[(wave * 16 + cs) * 32 + b] = acc[b];
        }
        __syncthreads();
        if (tid < 384) {
            const int cs2 = tid >> 5, b = tid & 31; float v = 0.f;
#pragma unroll
            for (int w = 0; w < 8; ++w) v += red[(w * 16 + cs2) * 32 + b];
            const int n = cb * 12 + cs2; v += b_ada[n];
            if (n < 1024) SHIFT[b * 1024 + n] = v;
            else if (n < 2048) MUL[b * 1024 + n - 1024] = norm_gain[n - 1024] * (1.f + v);
            else GATE[b * 1024 + n - 2048] = v;
        }
        __syncthreads();
    }
}

__device__ __forceinline__ int src_col(int n) {
    if (n >= DIN) return -1;
    if (n < 1024) { const int pc = n & 127; return (n & ~127) + (pc >> 1) + ((pc & 1) << 6); }
    return n;
}
__device__ __forceinline__ void transpose_item(const float* W, int N, bool permute, bf16* WT, LAS float* scr, int item, int nblk, int lane) {
    const int kb = item / nblk, nb = item % nblk, k0 = 64 * kb, n0 = 32 * nb;
    const int src = permute ? src_col(n0 + (lane & 31)) : n0 + (lane & 31);
#pragma unroll 8
    for (int i = 0; i < 32; ++i) { const int kk = 2 * i + (lane >> 5); scr[kk * 33 + (lane & 31)] = (src >= 0) ? W[(size_t)(k0 + kk) * N + src] : 0.f; }
    asm volatile("s_waitcnt lgkmcnt(0)" ::: "memory");
    const int c = lane & 7;
#pragma unroll
    for (int j = 0; j < 4; ++j) {
        const int n = (lane >> 3) + 8 * j; const LAS float* s = scr + (8 * c) * 33 + n;
        u32x4 o; o.x = pk2(s[0 * 33], s[1 * 33]); o.y = pk2(s[2 * 33], s[3 * 33]); o.z = pk2(s[4 * 33], s[5 * 33]); o.w = pk2(s[6 * 33], s[7 * 33]);
        *(u32x4*)(WT + (size_t)(n0 + n) * 1024 + k0 + 8 * c) = o;
    }
    asm volatile("s_waitcnt lgkmcnt(0)" ::: "memory");
}
__device__ __forceinline__ void phase_prep(LAS unsigned char* lds, const float* x, const float* w_in, const float* w_out, const float* MUL, const float* SHIFT, bf16* WIN, bf16* WOUT, bf16* H) {
    const int tid = threadIdx.x, lane = tid & 63, wave = tid >> 6;
    LAS float* scr = (LAS float*)(lds + wave * 16384);
    const int gw = blockIdx.x * 8 + wave, NGW = gridDim.x * 8;
    constexpr int I_IN = 16 * (NPAD / 32), I_OUT = 16 * (DM / 32);
    for (int it = gw; it < I_IN + I_OUT; it += NGW) {
        if (it < I_IN) transpose_item(w_in, DIN, true, WIN, scr, it, NPAD / 32, lane);
        else transpose_item(w_out, DM, false, WOUT, scr, it - I_IN, DM / 32, lane);
    }
    for (int m = gw; m < NT; m += NGW) {
        const f32x4* xr = (const f32x4*)(x + (size_t)m * DM) + lane;
        f32x4 v[4]; float ss = 0.f;
#pragma unroll
        for (int j = 0; j < 4; ++j) { v[j] = xr[64 * j]; ss += (v[j].x * v[j].x + v[j].y * v[j].y) + (v[j].z * v[j].z + v[j].w * v[j].w); }
        ss = wave_sum(ss);
        const float r = 1.0f / sqrtf(ss * (1.f / DM) + EPS);
        const int b = m >> 11;
        const f32x4* mr = (const f32x4*)(MUL + b * DM) + lane; const f32x4* sr = (const f32x4*)(SHIFT + b * DM) + lane;
        unsigned long long* o8 = (unsigned long long*)(H + (size_t)m * DM) + lane;
#pragma unroll
        for (int j = 0; j < 4; ++j) {
            const f32x4 hv = v[j] * r * mr[64 * j] + sr[64 * j];
            o8[64 * j] = (unsigned long long)pk2(hv.x, hv.y) | ((unsigned long long)pk2(hv.z, hv.w) << 32);
        }
    }
}

template <int DK, bool GLA>
__device__ __forceinline__ void stream_naive(LAS unsigned char* lds, const bf16* P, const float* GLR, const float* Wg, const float* bg, const float* gng, bf16* MIX, int b, int h) {
    constexpr int TB = 16, DPT = DK / 4;
    const int tid = threadIdx.x, e = tid & 127, dg = tid >> 7;
    LAS float* qs = (LAS float*)lds;
    LAS float* ks = qs + TB * DK;
    LAS float* as = ks + TB * DK;
    LAS float* vs = as + TB * DK;
    LAS float* part = vs + TB * 128;
    LAS float* wgs = part + 4 * TB * 128;
    const int qcol = GLA ? 2048 + 64 * h : 128 * h, kcol = GLA ? 2304 + 64 * h : 512 + 128 * h;
    const int vcol = GLA ? 2560 + 128 * h : 1024 + 128 * h, zcol = GLA ? 3072 + 128 * h : 1536 + 128 * h, ocol = GLA ? 512 + 128 * h : 128 * h;
    const float gamma = 1.f - exp2f(-5.f - (float)h);
    __syncthreads();
    if (GLA) { for (int i = tid; i < 16 * 64; i += 512) wgs[i] = Wg[(i >> 6) * 256 + 64 * h + (i & 63)]; if (tid < 64) wgs[1024 + tid] = bg[64 * h + tid]; }
    float R[DPT];
#pragma unroll
    for (int j = 0; j < DPT; ++j) R[j] = 0.f;
    const size_t tok0 = (size_t)b * SEQ;
    for (int t0 = 0; t0 < SEQ; t0 += TB) {
        __syncthreads();
        for (int i = tid; i < TB * DK; i += 512) {
            const int tt = i / DK, d = i % DK; const bf16* row = P + (tok0 + t0 + tt) * PW;
            qs[i] = bf2f(row[qcol + d]); ks[i] = bf2f(row[kcol + d]);
            if (GLA) {
                const float* g = GLR + (tok0 + t0 + tt) * 16; float z = wgs[1024 + d];
#pragma unroll
                for (int r = 0; r < 16; ++r) z += g[r] * wgs[r * 64 + d];
                const float ls = fminf(z, 0.f) - log1pf(__expf(-fabsf(z)));
                as[i] = __expf(ls * (1.f / 16.f));
            }
        }
        for (int i = tid; i < TB * 128; i += 512) { const int tt = i >> 7, ee = i & 127; vs[i] = bf2f(P[(tok0 + t0 + tt) * PW + vcol + ee]); }
        __syncthreads();
        for (int tt = 0; tt < TB; ++tt) {
            const float ve = vs[tt * 128 + e]; float py = 0.f;
#pragma unroll
            for (int j = 0; j < DPT; ++j) {
                const int d = dg * DPT + j; const float a = GLA ? as[tt * DK + d] : gamma;
                R[j] = a * R[j] + ks[tt * DK + d] * ve; py += qs[tt * DK + d] * R[j];
            }
            part[(dg * TB + tt) * 128 + e] = py;
        }
        __syncthreads();
        {
            const int tt = tid >> 5, e4 = (tid & 31) * 4; float y[4]; float ss = 0.f;
#pragma unroll
            for (int i = 0; i < 4; ++i) { y[i] = (part[(0 * TB + tt) * 128 + e4 + i] + part[(1 * TB + tt) * 128 + e4 + i]) + (part[(2 * TB + tt) * 128 + e4 + i] + part[(3 * TB + tt) * 128 + e4 + i]); ss += y[i] * y[i]; }
#pragma unroll
            for (int o = 1; o < 32; o <<= 1) ss += __shfl_xor(ss, o);
            const float r = 1.0f / sqrtf(ss * (1.f / 128.f) + EPS);
            const u32x2 zz = *(const u32x2*)(P + (tok0 + t0 + tt) * PW + zcol + e4);
            const float z0 = bf2f(zz.x & 0xffffu), z1 = bf2f(zz.x >> 16), z2 = bf2f(zz.y & 0xffffu), z3 = bf2f(zz.y >> 16);
            float g0 = 1.f, g1 = 1.f, g2 = 1.f, g3 = 1.f;
            if (GLA) { g0 = gng[e4]; g1 = gng[e4 + 1]; g2 = gng[e4 + 2]; g3 = gng[e4 + 3]; }
            u32x2 o; o.x = pk2(y[0] * r * g0 * z0, y[1] * r * g1 * z1); o.y = pk2(y[2] * r * g2 * z2, y[3] * r * g3 * z3);
            *(u32x2*)(MIX + (tok0 + t0 + tt) * DM + ocol + e4) = o;
        }
    }
}

__device__ __forceinline__ void phase_final(float* out, const float* final_gain) {
    const int tid = threadIdx.x, lane = tid & 63, wave = tid >> 6;
    const int gw = blockIdx.x * 8 + wave, NGW = gridDim.x * 8;
    f32x4 g[4];
#pragma unroll
    for (int j = 0; j < 4; ++j) g[j] = ((const f32x4*)final_gain)[lane + 64 * j];
    for (int m = gw; m < NT; m += NGW) {
        f32x4* xr = (f32x4*)(out + (size_t)m * DM) + lane;
        f32x4 v[4]; float ss = 0.f;
#pragma unroll
        for (int j = 0; j < 4; ++j) { v[j] = xr[64 * j]; ss += (v[j].x * v[j].x + v[j].y * v[j].y) + (v[j].z * v[j].z + v[j].w * v[j].w); }
        ss = wave_sum(ss);
        const float r = 1.0f / sqrtf(ss * (1.f / DM) + EPS);
#pragma unroll
        for (int j = 0; j < 4; ++j) xr[64 * j] = v[j] * r * g[j];
    }
}

struct Args { const float* in[11]; float* out; unsigned char* ws; int ph_lo, ph_hi; };
#ifndef ONE_LAUNCH
#define ONE_LAUNCH 1
#endif
constexpr int N_PHASES = 6;

template <bool COOP>
__global__ void __launch_bounds__(512, 2) fwd(Args a) {
    extern __shared__ __attribute__((aligned(16))) unsigned char lds_raw[];
    LAS unsigned char* lds = (LAS unsigned char*)lds_raw;
    const float* x = a.in[0]; const float* c = a.in[1]; const float* norm_gain = a.in[2]; const float* w_ada = a.in[3]; const float* b_ada = a.in[4];
    const float* w_in = a.in[5]; const float* w_gate = a.in[6]; const float* b_gate = a.in[7]; const float* gng = a.in[8]; const float* w_out = a.in[9]; const float* final_gain = a.in[10];
    unsigned char* ws = a.ws;
    float* MUL = (float*)(ws + WS_MUL); float* SHIFT = (float*)(ws + WS_SHIFT); float* GATE = (float*)(ws + WS_GATE);
    bf16* WIN = (bf16*)(ws + WS_WIN); bf16* WOUT = (bf16*)(ws + WS_WOUT); float* GLR = (float*)(ws + WS_GLR);
    bf16* H = (bf16*)(ws + WS_H); bf16* P = (bf16*)(ws + WS_P); bf16* MIX = (bf16*)(ws + WS_MIX);
    const int lo = a.ph_lo, hi = a.ph_hi;
#define IN(k) (lo <= (k) && (k) < hi)
#define SEAM(k) do { if (COOP) { if (IN(k) && IN((k) + 1)) cg::this_grid().sync(); } } while (0)
    if (IN(0)) phase_ada(lds, c, w_ada, b_ada, norm_gain, MUL, SHIFT, GATE);
    SEAM(0);
    if (IN(1)) phase_prep(lds, x, w_in, w_out, MUL, SHIFT, WIN, WOUT, H);
    SEAM(1);
    if (IN(2)) {
        pg8::Gemm g{H, WIN, NT, NPAD, DM}; pg8::StaticOrder S; S.init(NT, NPAD, (int)gridDim.x, (int)blockIdx.x);
        EpiP E{P, GLR};
        pg8::gemm_phase<EpiP, pg8::StaticOrder, true, true>(lds, g, S, E);
    }
    SEAM(2);
    if (IN(3)) {
        for (int s = blockIdx.x; s < 256; s += gridDim.x) {
            const int bh = s >> 1, b = bh >> 2, h = bh & 3;
            if (s & 1) stream_naive<64, true>(lds, P, GLR, w_gate, b_gate, gng, MIX, b, h);
            else stream_naive<128, false>(lds, P, GLR, w_gate, b_gate, gng, MIX, b, h);
        }
    }
    SEAM(3);
    if (IN(4)) {
        pg8::Gemm g{MIX, WOUT, NT, DM, DM}; pg8::StaticOrder S; S.init(NT, DM, (int)gridDim.x, (int)blockIdx.x);
        EpiOut E{x, GATE, a.out};
        pg8::gemm_phase<EpiOut, pg8::StaticOrder, true, true>(lds, g, S, E);
    }
    SEAM(4);
    if (IN(5)) phase_final(a.out, final_gain);
#undef IN
#undef SEAM
}

extern "C" void kernel_launch(void* const* d_in, const int* in_sizes, int n_in, void* d_out, int out_size, void* d_ws, size_t ws_size, hipStream_t stream) {
    static int grid = 0;
    if (grid == 0) {
        if (n_in != 11 || in_sizes[0] != NT * DM || out_size != NT * DM || ws_size < WS_END) { fprintf(stderr, "kernel_launch: unexpected shapes (n_in %d, in0 %d, out %d, ws %zu)\n", n_in, n_in > 0 ? in_sizes[0] : -1, out_size, ws_size); grid = -1; return; }
        int dev = 0, cus = 0, per_cu = 0;
        if (hipGetDevice(&dev) != hipSuccess || hipDeviceGetAttribute(&cus, hipDeviceAttributeMultiprocessorCount, dev) != hipSuccess) { grid = -1; return; }
        (void)hipFuncSetAttribute((const void*)fwd<true>, hipFuncAttributeMaxDynamicSharedMemorySize, LDS_BYTES);
        (void)hipFuncSetAttribute((const void*)fwd<false>, hipFuncAttributeMaxDynamicSharedMemorySize, LDS_BYTES);
        if (hipOccupancyMaxActiveBlocksPerMultiprocessor(&per_cu, (const void*)fwd<true>, 512, LDS_BYTES) != hipSuccess || per_cu < 1) { fprintf(stderr, "kernel_launch: occupancy query says %d blocks per CU\n", per_cu); per_cu = 1; }
        (void)hipGetLastError();
        grid = cus;
    }
    if (grid < 0) return;
    Args a{};
    for (int i = 0; i < 11; ++i) a.in[i] = (const float*)d_in[i];
    a.out = (float*)d_out; a.ws = (unsigned char*)d_ws;
#if ONE_LAUNCH
    a.ph_lo = 0; a.ph_hi = N_PHASES;
    void* args[] = {&a};
    hipError_t e = hipLaunchCooperativeKernel((const void*)fwd<true>, dim3(grid), dim3(512), args, LDS_BYTES, stream);
    if (e != hipSuccess) fprintf(stderr, "cooperative launch failed: %s (grid %d)\n", hipGetErrorString(e), grid);
#else
    for (int p = 0; p < N_PHASES; ++p) {
        a.ph_lo = p; a.ph_hi = p + 1;
        hipLaunchKernelGGL(fwd<false>, dim3(grid), dim3(512), LDS_BYTES, stream, a);
    }
#endif
}
```

```cpp
#include <hip/hip_runtime.h>
#include <hip/hip_cooperative_groups.h>
#include <cstdio>
#include <cstdint>
namespace cg = cooperative_groups;
namespace pg8 {
#define PG8_LAS __attribute__((address_space(3)))
typedef unsigned short bf16_t;
typedef short bf16x8 __attribute__((ext_vector_type(8)));
typedef float f32x4 __attribute__((ext_vector_type(4)));
typedef unsigned u32x4 __attribute__((ext_vector_type(4)));
constexpr int BM = 256, BK = 64, HALF = 128, HTB = HALF * BK * 2  , STAGE_BYTES = 8 * HTB, NXCD = 8, WGM = 8;

__host__ __device__ __forceinline__ int lds_byte(int r, int c) { const int st = (r >> 4) * 2 + (c >> 5), rr = r & 15, cc = c & 31, ob = rr * 64 + cc * 2; return st * 1024 + (ob ^ (((ob >> 9) & 1) << 5)); }
__host__ __device__ __forceinline__ void stage_rc(int b, int& R, int& C) { const int st = b / 1024, sb = b % 1024, swz = sb ^ (((sb >> 9) & 1) << 5); R = (st >> 1) * 16 + swz / 64; C = (st & 1) * 32 + (swz % 64) / 2; }
__host__ __device__ __forceinline__ int perm32(int rho) { const int n = rho >> 4, i = rho & 15; return 8 * (i >> 2) + 4 * n + (i & 3); }

struct Unit { int pm, pn; };
struct Gemm { const bf16_t* A; const bf16_t* Bt; int M, N, K; };

struct StaticOrder {
    int nM, nN, nwg, G, c;
    __host__ __device__ void init(int M, int N, int G_, int c_) { nM = M / BM; nN = N / BM; nwg = nM * nN; G = G_; c = c_; }
    __host__ __device__ bool next(int i, Unit& u) const {
        const long L = (long)i * G + c; if (L >= nwg) return false;
        int wgid = (int)L; { const int q = nwg / NXCD, r = nwg % NXCD, xcd = wgid % NXCD, off = wgid / NXCD; wgid = (xcd < r ? xcd * (q + 1) : r * (q + 1) + (xcd - r) * q) + off; }
        const int nig = WGM * nN, gid = wgid / nig, fm = gid * WGM, gsz = (nM - fm) < WGM ? (nM - fm) : WGM;
        u.pm = fm + ((wgid % nig) % gsz); u.pn = (wgid % nig) / gsz; return true;
    }
    __device__ __forceinline__ void a_ready(const Unit&) const {}
    __device__ __forceinline__ void done(const Unit&) const {}
};

__device__ __forceinline__ unsigned cvt_pk_bf16(float lo, float hi) { unsigned r; asm volatile("v_cvt_pk_bf16_f32 %0, %1, %2" : "=v"(r) : "v"(lo), "v"(hi)); return r; }
typedef float f32x2 __attribute__((ext_vector_type(2)));
__device__ __forceinline__ f32x2 gelu_pk(f32x2 v) {
    const f32x2 av = __builtin_elementwise_abs(v), d = av * 0.2316418882f + 1.0f;
    f32x2 t; t.x = __builtin_amdgcn_rcpf(d.x); t.y = __builtin_amdgcn_rcpf(d.y);
    f32x2 q = t * 0.5307027145f + (-0.7265760135f); q = q * t + 0.7107068705f; q = q * t + (-0.142248368f); q = q * t + 0.127414796f; q = q * t;
    const f32x2 s = (v * v) * (-0.72134752044f);
    f32x2 e; e.x = __builtin_amdgcn_exp2f(s.x); e.y = __builtin_amdgcn_exp2f(s.y);
    const f32x2 m = v * (q * e), r = v - m;
    f32x2 o; o.x = v.x < 0.f ? m.x : r.x; o.y = v.y < 0.f ? m.y : r.y; return o;
}

template <int ACT  > struct EpiBf16 {
    static constexpr bool PERM = true, AFTER_DRAIN = false; static_assert(ACT == 0 || ACT == 1, "EpiBf16: ACT is 0 (none) or 1 (gelu_pk)");
    bf16_t* O; int ldc; const float* bias; int split_cols; size_t split_stride; float scale0;
    __device__ __forceinline__ void operator()(const f32x4 (&acc)[2][2][4][2], const Unit& u, int wr, int wc, int fr, int fq) const {
        const int row0 = u.pm * BM + wr * 64 + fr; int colt = u.pn * BM; bf16_t* base = O;
        float sc = 1.f; if (split_cols) { const int t = colt / split_cols; base += (size_t)t * split_stride; colt -= t * split_cols; if (t == 0) sc = scale0; }
        const int col0 = colt + wc * 32 + 8 * fq, bcol0 = u.pn * BM + wc * 32 + 8 * fq;
        f32x4 bv[2][2];
#pragma unroll
        for (int bj = 0; bj < 2; ++bj)
#pragma unroll
            for (int n = 0; n < 2; ++n) bv[bj][n] = bias ? *(const f32x4*)(bias + bcol0 + bj * HALF + 4 * n) : (f32x4){0.f, 0.f, 0.f, 0.f};
#pragma unroll
        for (int ai = 0; ai < 2; ++ai)
#pragma unroll
            for (int m = 0; m < 4; ++m) { bf16_t* rowp = base + (size_t)(row0 + ai * HALF + m * 16) * ldc + col0;
#pragma unroll
                for (int bj = 0; bj < 2; ++bj) { f32x4 v0 = acc[ai][bj][m][0] + bv[bj][0], v1 = acc[ai][bj][m][1] + bv[bj][1];
                    if (ACT == 1) { f32x2 a = gelu_pk((f32x2){v0[0], v0[1]}), b = gelu_pk((f32x2){v0[2], v0[3]}), c = gelu_pk((f32x2){v1[0], v1[1]}), d = gelu_pk((f32x2){v1[2], v1[3]});
                        v0 = (f32x4){a.x, a.y, b.x, b.y}; v1 = (f32x4){c.x, c.y, d.x, d.y}; }
                    v0 = v0 * sc; v1 = v1 * sc; u32x4 w; w.x = cvt_pk_bf16(v0[0], v0[1]); w.y = cvt_pk_bf16(v0[2], v0[3]); w.z = cvt_pk_bf16(v1[0], v1[1]); w.w = cvt_pk_bf16(v1[2], v1[3]);
                    *(u32x4*)(rowp + bj * HALF) = w; } }
    }
};
template <class Epi, class Sched, bool ALIGN_EPI = false, bool SP2 = false>
__device__ __forceinline__ void gemm_phase(PG8_LAS unsigned char* lds, const Gemm g, const Sched& S, const Epi& E) {
    const int tid = threadIdx.x, wid = __builtin_amdgcn_readfirstlane(tid >> 6), lane = tid & 63, wr = wid >> 2, wc = wid & 3, fr = lane & 15, fq = lane >> 4;
    const int K = g.K, nt = K / BK;
    unsigned voffA[2], voffB[2];
#pragma unroll
    for (int i = 0; i < 2; ++i) { int R, C; stage_rc(tid * 16 + i * 8192, R, C); const int Rb = Epi::PERM ? ((R & ~31) + perm32(R & 31)) : R;
        voffA[i] = (unsigned)(R * K + C) * 2u; voffB[i] = (unsigned)(Rb * K + C) * 2u; }
    const size_t kstep = (size_t)(BK * 2);
    const size_t hstep = (size_t)HALF * K * 2;
    const size_t tstep = 2 * hstep;
    const unsigned ldsw = (unsigned)wid * 1024u;
    const int aoff = lds_byte(wr * 64 + fr, fq * 8), boff = lds_byte(wc * 32 + fr, fq * 8);
#define PG8_SA(b, h) (((b) * 2 + (h)) * HTB)
#define PG8_SB(b, h) ((4 + (b) * 2 + (h)) * HTB)
#define PG8_STAGE(bufoff, gbase, voff) do { _Pragma("unroll") for (int _i = 0; _i < 2; ++_i) \
        __builtin_amdgcn_global_load_lds((const unsigned*)((const char*)(gbase) + (voff)[_i]), (PG8_LAS unsigned*)(lds + (bufoff) + ldsw + _i * 8192), 16, 0, 0); } while (0)
#define PG8_LDA(dst, b, h) do { _Pragma("unroll") for (int m = 0; m < 4; ++m) _Pragma("unroll") for (int k = 0; k < 2; ++k) dst[m][k] = *(const PG8_LAS bf16x8*)(lds + PG8_SA(b, h) + aoff + m * 2048 + k * 1024); } while (0)
#define PG8_LDB(dst, b, h) do { _Pragma("unroll") for (int n = 0; n < 2; ++n) _Pragma("unroll") for (int k = 0; k < 2; ++k) dst[n][k] = *(const PG8_LAS bf16x8*)(lds + PG8_SB(b, h) + boff + n * 2048 + k * 1024); } while (0)
#define PG8_MMA(ai, bj, At, Bt) do { __builtin_amdgcn_s_setprio(1); _Pragma("unroll") for (int m = 0; m < 4; ++m) _Pragma("unroll") for (int n = 0; n < 2; ++n) _Pragma("unroll") for (int k = 0; k < 2; ++k) \
        acc[ai][bj][m][n] = __builtin_amdgcn_mfma_f32_16x16x32_bf16(Bt[n][k], At[m][k], acc[ai][bj][m][n], 0, 0, 0); __builtin_amdgcn_s_setprio(0); } while (0)
#define PG8_WAIT_V(n) asm volatile("s_waitcnt vmcnt(" #n ")" ::: "memory")
#define PG8_WAIT_L(n) asm volatile("s_waitcnt lgkmcnt(" #n ")" ::: "memory")
#define PG8_BAR __builtin_amdgcn_s_barrier()
#define PG8_SCHED __builtin_amdgcn_sched_barrier(0)
    Unit cur, nxt; int ui = 0;
    if (!S.next(0, cur)) return;
    f32x4 acc[2][2][4][2];
#pragma unroll
    for (int a = 0; a < 2; ++a)
#pragma unroll
        for (int b = 0; b < 2; ++b)
#pragma unroll
            for (int m = 0; m < 4; ++m)
#pragma unroll
                for (int n = 0; n < 2; ++n) acc[a][b][m][n] = (f32x4){0.f, 0.f, 0.f, 0.f};
    bf16x8 At[4][2], B0[2][2], B1[2][2];
    const char* cA = (const char*)g.A + (size_t)cur.pm * tstep; const char* cB = (const char*)g.Bt + (size_t)cur.pn * tstep;
    S.a_ready(cur);
    if constexpr (SP2) {
        PG8_STAGE(PG8_SB(0, 0), cB, voffB); PG8_STAGE(PG8_SB(0, 1), cB + hstep, voffB); PG8_STAGE(PG8_SA(0, 0), cA, voffA); PG8_STAGE(PG8_SA(0, 1), cA + hstep, voffA);
        if (wr == 1) PG8_BAR;
        PG8_WAIT_V(2); PG8_BAR;
        PG8_STAGE(PG8_SB(1, 0), cB + kstep, voffB); PG8_STAGE(PG8_SA(1, 0), cA + kstep, voffA); PG8_STAGE(PG8_SB(1, 1), cB + hstep + kstep, voffB);
        PG8_WAIT_V(6); PG8_BAR;
    } else {
        PG8_STAGE(PG8_SB(0, 0), cB, voffB); PG8_STAGE(PG8_SA(0, 0), cA, voffA); PG8_STAGE(PG8_SB(0, 1), cB + hstep, voffB); PG8_STAGE(PG8_SA(0, 1), cA + hstep, voffA);
        if (wr == 1) PG8_BAR;
        PG8_WAIT_V(4); PG8_BAR;
        PG8_STAGE(PG8_SB(1, 0), cB + kstep, voffB); PG8_STAGE(PG8_SA(1, 0), cA + kstep, voffA); PG8_STAGE(PG8_SB(1, 1), cB + hstep + kstep, voffB);
        PG8_WAIT_V(6); PG8_BAR;
    }
    for (;;) {
        const bool has_next = S.next(ui + 1, nxt);
        const char* nA = has_next ? (const char*)g.A + (size_t)nxt.pm * tstep : cA; const char* nB = has_next ? (const char*)g.Bt + (size_t)nxt.pn * tstep : cB;
        for (int t = 0; t < nt; t += 2) {
            const bool last = (t == nt - 2);
            const char* a1 = cA + (size_t)(t + 1) * kstep;
            const char* a2 = last ? nA : cA + (size_t)(t + 2) * kstep; const char* b2 = last ? nB : cB + (size_t)(t + 2) * kstep;
            const char* a3 = a2 + kstep; const char* b3 = b2 + kstep;
            if (last && has_next) S.a_ready(nxt);
            if constexpr (SP2) {
            PG8_LDB(B0, 0, 0); PG8_LDB(B1, 0, 1); PG8_SCHED; PG8_LDA(At, 0, 0); PG8_STAGE(PG8_SA(1, 1), a1 + hstep, voffA);
            PG8_WAIT_V(8); PG8_WAIT_L(0); PG8_BAR; PG8_MMA(0, 0, At, B0); PG8_MMA(0, 1, At, B1); PG8_BAR; PG8_SCHED;
            PG8_LDA(At, 0, 1); PG8_STAGE(PG8_SB(0, 0), b2, voffB); PG8_STAGE(PG8_SB(0, 1), b2 + hstep, voffB); PG8_STAGE(PG8_SA(0, 0), a2, voffA);
            PG8_WAIT_V(8); PG8_WAIT_L(0); PG8_BAR; PG8_MMA(1, 0, At, B0); PG8_MMA(1, 1, At, B1); PG8_BAR; PG8_SCHED;
            PG8_LDB(B0, 1, 0); PG8_LDB(B1, 1, 1); PG8_SCHED; PG8_LDA(At, 1, 0); PG8_STAGE(PG8_SA(0, 1), a2 + hstep, voffA);
            PG8_WAIT_V(8); PG8_WAIT_L(0); PG8_BAR; PG8_MMA(0, 0, At, B0); PG8_MMA(0, 1, At, B1); PG8_BAR; PG8_SCHED;
            PG8_LDA(At, 1, 1); PG8_STAGE(PG8_SB(1, 0), b3, voffB); PG8_STAGE(PG8_SB(1, 1), b3 + hstep, voffB); PG8_STAGE(PG8_SA(1, 0), a3, voffA);
            PG8_WAIT_V(8); PG8_WAIT_L(0); PG8_BAR; PG8_MMA(1, 0, At, B0); PG8_MMA(1, 1, At, B1); PG8_BAR; PG8_SCHED;
            } else {
            PG8_LDB(B0, 0, 0); PG8_SCHED; PG8_LDA(At, 0, 0); PG8_STAGE(PG8_SA(1, 1), a1 + hstep, voffA);
            PG8_WAIT_L(8); PG8_BAR; PG8_WAIT_L(0); PG8_MMA(0, 0, At, B0); PG8_BAR; PG8_SCHED;
            PG8_LDB(B1, 0, 1); PG8_STAGE(PG8_SB(0, 0), b2, voffB);
            PG8_BAR; PG8_WAIT_L(0); PG8_MMA(0, 1, At, B1); PG8_BAR;
            PG8_LDA(At, 0, 1); PG8_STAGE(PG8_SA(0, 0), a2, voffA);
            PG8_BAR; PG8_WAIT_L(0); PG8_MMA(1, 0, At, B0); PG8_BAR; PG8_SCHED;
            PG8_STAGE(PG8_SB(0, 1), b2 + hstep, voffB);
            PG8_WAIT_V(6); PG8_BAR; PG8_MMA(1, 1, At, B1); PG8_BAR;
            PG8_LDB(B0, 1, 0); PG8_SCHED; PG8_LDA(At, 1, 0); PG8_STAGE(PG8_SA(0, 1), a2 + hstep, voffA);
            PG8_WAIT_L(8); PG8_BAR; PG8_WAIT_L(0); PG8_MMA(0, 0, At, B0); PG8_BAR; PG8_SCHED;
            PG8_LDB(B1, 1, 1); PG8_STAGE(PG8_SB(1, 0), b3, voffB);
            PG8_BAR; PG8_WAIT_L(0); PG8_MMA(0, 1, At, B1); PG8_BAR;
            PG8_LDA(At, 1, 1); PG8_STAGE(PG8_SA(1, 0), a3, voffA);
            PG8_BAR; PG8_WAIT_L(0); PG8_MMA(1, 0, At, B0); PG8_BAR; PG8_SCHED;
            PG8_STAGE(PG8_SB(1, 1), b3 + hstep, voffB);
            PG8_WAIT_V(6); PG8_BAR; PG8_MMA(1, 1, At, B1); PG8_BAR;
            }
        }
        if constexpr (ALIGN_EPI) { if (wr == 0) PG8_BAR; }
        if constexpr (!Epi::AFTER_DRAIN) { E(acc, cur, wr, wc, fr, fq); S.done(cur); }
        if (!has_next) break;
#pragma unroll
        for (int a = 0; a < 2; ++a)
#pragma unroll
            for (int b = 0; b < 2; ++b)
#pragma unroll
                for (int m = 0; m < 4; ++m)
#pragma unroll
                    for (int n = 0; n < 2; ++n) acc[a][b][m][n] = (f32x4){0.f, 0.f, 0.f, 0.f};
        cur = nxt; cA = nA; cB = nB; ++ui;
        if constexpr (ALIGN_EPI) { if (wr == 1) PG8_BAR; }
    }
    PG8_WAIT_V(0);
    if constexpr (!ALIGN_EPI) { if (wr == 0) PG8_BAR; }
    PG8_BAR;
    if constexpr (Epi::AFTER_DRAIN) { E.fused(acc, cur, wr, wc, fr, fq, lds, wid, lane); S.done(cur); }
#undef PG8_SA
#undef PG8_SB
#undef PG8_STAGE
#undef PG8_LDA
#undef PG8_LDB
#undef PG8_MMA
#undef PG8_WAIT_V
#undef PG8_WAIT_L
#undef PG8_BAR
#undef PG8_SCHED
}
}

constexpr int NB = 32, SEQ = 2048, DM = 1024, NT = NB * SEQ;
constexpr int DIN = 3600, NPAD = 3840, PW = 3584;
constexpr float EPS = 1e-6f;
constexpr size_t MiB = 1u << 20;
constexpr size_t WS_MUL = 1 * MiB, WS_SHIFT = WS_MUL + 131072, WS_GATE = WS_SHIFT + 131072;
constexpr size_t WS_WIN = 2 * MiB;
constexpr size_t WS_WOUT = 10 * MiB;
constexpr size_t WS_GLR = 12 * MiB;
constexpr size_t WS_H = 16 * MiB;
constexpr size_t WS_P = 144 * MiB;
constexpr size_t WS_MIX = 592 * MiB;
constexpr size_t WS_END = 720 * MiB;
constexpr int LDS_BYTES = 147456;

#define LAS __attribute__((address_space(3)))
typedef unsigned short bf16;
typedef float f32x4 __attribute__((ext_vector_type(4)));
typedef unsigned u32x4 __attribute__((ext_vector_type(4)));
typedef unsigned u32x2 __attribute__((ext_vector_type(2)));

__device__ __forceinline__ unsigned f2bf(float f) { unsigned u = __builtin_bit_cast(unsigned, f); return (u + 0x7fffu + ((u >> 16) & 1u)) >> 16; }
__device__ __forceinline__ unsigned pk2(float lo, float hi) { return f2bf(lo) | (f2bf(hi) << 16); }
__device__ __forceinline__ float bf2f(unsigned v) { return __builtin_bit_cast(float, v << 16); }
__device__ __forceinline__ float wave_sum(float v) {
#pragma unroll
    for (int o = 1; o < 64; o <<= 1) v += __shfl_xor(v, o);
    return v;
}
__device__ __forceinline__ float silu_f(float v) { return v / (1.f + __expf(-v)); }

struct EpiP {
    static constexpr bool PERM = true, AFTER_DRAIN = false;
    bf16* P; float* GLR;
    __device__ __forceinline__ void operator()(const pg8::f32x4 (&acc)[2][2][4][2], const pg8::Unit& u, int wr, int wc, int fr, int fq) const {
        const int pn = u.pn;
        const int row0 = u.pm * 256 + wr * 64 + fr;
        const int cl = wc * 32 + 8 * fq;
        if (pn < 4) {
            const float sc = (pn >= 2) ? 0.08838834764831845f : 1.0f;
            float frev[4];
#pragma unroll
            for (int j = 0; j < 4; ++j) frev[j] = exp2f(-(float)(16 * wc + 4 * fq + j) * 0.20762050593046014f) * 0.15915494309189535f;
#pragma unroll
            for (int ai = 0; ai < 2; ++ai)
#pragma unroll
                for (int m = 0; m < 4; ++m) {
                    const int row = row0 + ai * 128 + m * 16;
                    const float pos = (float)(row & (SEQ - 1));
                    float sn[4], cs[4];
#pragma unroll
                    for (int j = 0; j < 4; ++j) { const float rev = __builtin_amdgcn_fractf(pos * frev[j]); sn[j] = __builtin_amdgcn_sinf(rev) * sc; cs[j] = __builtin_amdgcn_cosf(rev) * sc; }
#pragma unroll
                    for (int bj = 0; bj < 2; ++bj) {
                        const pg8::f32x4 v0 = acc[ai][bj][m][0], v1 = acc[ai][bj][m][1];
                        u32x4 w;
                        w.x = pk2(v0[0] * cs[0] - v0[1] * sn[0], v0[0] * sn[0] + v0[1] * cs[0]);
                        w.y = pk2(v0[2] * cs[1] - v0[3] * sn[1], v0[2] * sn[1] + v0[3] * cs[1]);
                        w.z = pk2(v1[0] * cs[2] - v1[1] * sn[2], v1[0] * sn[2] + v1[1] * cs[2]);
                        w.w = pk2(v1[2] * cs[3] - v1[3] * sn[3], v1[2] * sn[3] + v1[3] * cs[3]);
                        *(u32x4*)(P + (size_t)row * PW + pn * 256 + bj * 128 + cl) = w;
                    }
                }
        } else if (pn < 14) {
            const bool act = (pn == 6 || pn == 7 || pn == 12 || pn == 13);
            const float sc = (pn == 8) ? 0.125f : 1.0f;
#pragma unroll
            for (int ai = 0; ai < 2; ++ai)
#pragma unroll
                for (int m = 0; m < 4; ++m) {
                    const int row = row0 + ai * 128 + m * 16;
#pragma unroll
                    for (int bj = 0; bj < 2; ++bj) {
                        pg8::f32x4 v0 = acc[ai][bj][m][0] * sc, v1 = acc[ai][bj][m][1] * sc;
                        if (act) {
#pragma unroll
                            for (int i = 0; i < 4; ++i) { v0[i] = silu_f(v0[i]); v1[i] = silu_f(v1[i]); }
                        }
                        u32x4 w; w.x = pk2(v0[0], v0[1]); w.y = pk2(v0[2], v0[3]); w.z = pk2(v1[0], v1[1]); w.w = pk2(v1[2], v1[3]);
                        *(u32x4*)(P + (size_t)row * PW + pn * 256 + bj * 128 + cl) = w;
                    }
                }
        } else {
            if (wc == 0 && fq < 2) {
#pragma unroll
                for (int ai = 0; ai < 2; ++ai)
#pragma unroll
                    for (int m = 0; m < 4; ++m) {
                        const int row = row0 + ai * 128 + m * 16;
                        *(pg8::f32x4*)(GLR + (size_t)row * 16 + 8 * fq) = acc[ai][0][m][0];
                        *(pg8::f32x4*)(GLR + (size_t)row * 16 + 8 * fq + 4) = acc[ai][0][m][1];
                    }
            }
        }
    }
};
struct EpiOut {
    static constexpr bool PERM = false, AFTER_DRAIN = false;
    const float* x; const float* gate; float* out;
    __device__ __forceinline__ void operator()(const pg8::f32x4 (&acc)[2][2][4][2], const pg8::Unit& u, int wr, int wc, int fr, int fq) const {
        const int row0 = u.pm * 256 + wr * 64 + fr, col0 = u.pn * 256 + wc * 32 + 4 * fq, b = u.pm >> 3;
        pg8::f32x4 g[2][2];
#pragma unroll
        for (int bj = 0; bj < 2; ++bj)
#pragma unroll
            for (int n = 0; n < 2; ++n) g[bj][n] = *(const pg8::f32x4*)(gate + b * DM + col0 + bj * 128 + n * 16);
#pragma unroll
        for (int ai = 0; ai < 2; ++ai)
#pragma unroll
            for (int m = 0; m < 4; ++m) {
                const size_t ro = (size_t)(row0 + ai * 128 + m * 16) * DM + col0;
#pragma unroll
                for (int bj = 0; bj < 2; ++bj)
#pragma unroll
                    for (int n = 0; n < 2; ++n) {
                        const size_t off = ro + bj * 128 + n * 16;
                        const pg8::f32x4 xv = *(const pg8::f32x4*)(x + off);
                        *(pg8::f32x4*)(out + off) = xv + g[bj][n] * acc[ai][bj][m][n];
                    }
            }
    }
};

__device__ __forceinline__ void phase_ada(LAS unsigned char* lds, const float* c, const float* w_ada, const float* b_ada, const float* norm_gain, float* MUL, float* SHIFT, float* GATE) {
    const int tid = threadIdx.x, lane = tid & 63, wave = tid >> 6;
    LAS float* sc = (LAS float*)lds;
    LAS float* red = (LAS float*)(lds + 131072);
    for (int i = tid; i < NB * DM; i += 512) sc[i] = silu_f(c[i]);
    __syncthreads();
    const int kg = tid >> 4, cs = tid & 15;
    for (int cb = blockIdx.x; cb < 256; cb += gridDim.x) {
        float acc[32];
#pragma unroll
        for (int b = 0; b < 32; ++b) acc[b] = 0.f;
        if (cs < 12) {
            const float* wp = w_ada + cb * 12 + cs;
            for (int k = kg; k < DM; k += 32) {
                const float w = wp[(size_t)k * 3072];
#pragma unroll
                for (int b = 0; b < 32; ++b) acc[b] += sc[b * 1024 + k] * w;
            }
        }
#pragma unroll
        for (int b = 0; b < 32; ++b) { acc[b] += __shfl_xor(acc[b], 16); acc[b] += __shfl_xor(acc[b], 32); }
        if (lane < 16) {
#pragma unroll
            for (int b = 0; b < 32; ++b) red[(wave * 16 + cs) * 32 + b] = acc[b];
        }
        __syncthreads();
        if (tid < 384) {
            const int cs2 = tid >> 5, b = tid & 31; float v = 0.f;
#pragma unroll
            for (int w = 0; w < 8; ++w) v += red[(w * 16 + cs2) * 32 + b];
            const int n = cb * 12 + cs2; v += b_ada[n];
            if (n < 1024) SHIFT[b * 1024 + n] = v;
            else if (n < 2048) MUL[b * 1024 + n - 1024] = norm_gain[n - 1024] * (1.f + v);
            else GATE[b * 1024 + n - 2048] = v;
        }
        __syncthreads();
    }
}

__device__ __forceinline__ int src_col(int n) {
    if (n >= DIN) return -1;
    if (n < 1024) { const int pc = n & 127; return (n & ~127) + (pc >> 1) + ((pc & 1) << 6); }
    return n;
}
__device__ __forceinline__ void transpose_item(const float* W, int N, bool permute, bf16* WT, LAS float* scr, int item, int nblk, int lane) {
    const int kb = item / nblk, nb = item % nblk, k0 = 64 * kb, n0 = 32 * nb;
    const int src = permute ? src_col(n0 + (lane & 31)) : n0 + (lane & 31);
#pragma unroll 8
    for (int i = 0; i < 32; ++i) { const int kk = 2 * i + (lane >> 5); scr[kk * 33 + (lane & 31)] = (src >= 0) ? W[(size_t)(k0 + kk) * N + src] : 0.f; }
    asm volatile("s_waitcnt lgkmcnt(0)" ::: "memory");
    const int c = lane & 7;
#pragma unroll
    for (int j = 0; j < 4; ++j) {
        const int n = (lane >> 3) + 8 * j; const LAS float* s = scr + (8 * c) * 33 + n;
        u32x4 o; o.x = pk2(s[0 * 33], s[1 * 33]); o.y = pk2(s[2 * 33], s[3 * 33]); o.z = pk2(s[4 * 33], s[5 * 33]); o.w = pk2(s[6 * 33], s[7 * 33]);
        *(u32x4*)(WT + (size_t)(n0 + n) * 1024 + k0 + 8 * c) = o;
    }
    asm volatile("s_waitcnt lgkmcnt(0)" ::: "memory");
}
__device__ __forceinline__ void phase_prep(LAS unsigned char* lds, const float* x, const float* w_in, const float* w_out, const float* MUL, const float* SHIFT, bf16* WIN, bf16* WOUT, bf16* H) {
    const int tid = threadIdx.x, lane = tid & 63, wave = tid >> 6;
    LAS float* scr = (LAS float*)(lds + wave * 16384);
    const int gw = blockIdx.x * 8 + wave, NGW = gridDim.x * 8;
    constexpr int I_IN = 16 * (NPAD / 32), I_OUT = 16 * (DM / 32);
    for (int it = gw; it < I_IN + I_OUT; it += NGW) {
        if (it < I_IN) transpose_item(w_in, DIN, true, WIN, scr, it, NPAD / 32, lane);
        else transpose_item(w_out, DM, false, WOUT, scr, it - I_IN, DM / 32, lane);
    }
    for (int m = gw; m < NT; m += NGW) {
        const f32x4* xr = (const f32x4*)(x + (size_t)m * DM) + lane;
        f32x4 v[4]; float ss = 0.f;
#pragma unroll
        for (int j = 0; j < 4; ++j) { v[j] = xr[64 * j]; ss += (v[j].x * v[j].x + v[j].y * v[j].y) + (v[j].z * v[j].z + v[j].w * v[j].w); }
        ss = wave_sum(ss);
        const float r = 1.0f / sqrtf(ss * (1.f / DM) + EPS);
        const int b = m >> 11;
        const f32x4* mr = (const f32x4*)(MUL + b * DM) + lane; const f32x4* sr = (const f32x4*)(SHIFT + b * DM) + lane;
        unsigned long long* o8 = (unsigned long long*)(H + (size_t)m * DM) + lane;
#pragma unroll
        for (int j = 0; j < 4; ++j) {
            const f32x4 hv = v[j] * r * mr[64 * j] + sr[64 * j];
            o8[64 * j] = (unsigned long long)pk2(hv.x, hv.y) | ((unsigned long long)pk2(hv.z, hv.w) << 32);
        }
    }
}

template <int DK, bool GLA>
__device__ __forceinline__ void stream_naive(LAS unsigned char* lds, const bf16* P, const float* GLR, const float* Wg, const float* bg, const float* gng, bf16* MIX, int b, int h) {
    constexpr int TB = 16, DPT = DK / 4;
    const int tid = threadIdx.x, e = tid & 127, dg = tid >> 7;
    LAS float* qs = (LAS float*)lds;
    LAS float* ks = qs + TB * DK;
    LAS float* as = ks + TB * DK;
    LAS float* vs = as + TB * DK;
    LAS float* part = vs + TB * 128;
    LAS float* wgs = part + 4 * TB * 128;
    const int qcol = GLA ? 2048 + 64 * h : 128 * h, kcol = GLA ? 2304 + 64 * h : 512 + 128 * h;
    const int vcol = GLA ? 2560 + 128 * h : 1024 + 128 * h, zcol = GLA ? 3072 + 128 * h : 1536 + 128 * h, ocol = GLA ? 512 + 128 * h : 128 * h;
    const float gamma = 1.f - exp2f(-5.f - (float)h);
    __syncthreads();
    if (GLA) { for (int i = tid; i < 16 * 64; i += 512) wgs[i] = Wg[(i >> 6) * 256 + 64 * h + (i & 63)]; if (tid < 64) wgs[1024 + tid] = bg[64 * h + tid]; }
    float R[DPT];
#pragma unroll
    for (int j = 0; j < DPT; ++j) R[j] = 0.f;
    const size_t tok0 = (size_t)b * SEQ;
    for (int t0 = 0; t0 < SEQ; t0 += TB) {
        __syncthreads();
        for (int i = tid; i < TB * DK; i += 512) {
            const int tt = i / DK, d = i % DK; const bf16* row = P + (tok0 + t0 + tt) * PW;
            qs[i] = bf2f(row[qcol + d]); ks[i] = bf2f(row[kcol + d]);
            if (GLA) {
                const float* g = GLR + (tok0 + t0 + tt) * 16; float z = wgs[1024 + d];
#pragma unroll
                for (int r = 0; r < 16; ++r) z += g[r] * wgs[r * 64 + d];
                const float ls = fminf(z, 0.f) - log1pf(__expf(-fabsf(z)));
                as[i] = __expf(ls * (1.f / 16.f));
            }
        }
        for (int i = tid; i < TB * 128; i += 512) { const int tt = i >> 7, ee = i & 127; vs[i] = bf2f(P[(tok0 + t0 + tt) * PW + vcol + ee]); }
        __syncthreads();
        for (int tt = 0; tt < TB; ++tt) {
            const float ve = vs[tt * 128 + e]; float py = 0.f;
#pragma unroll
            for (int j = 0; j < DPT; ++j) {
                const int d = dg * DPT + j; const float a = GLA ? as[tt * DK + d] : gamma;
                R[j] = a * R[j] + ks[tt * DK + d] * ve; py += qs[tt * DK + d] * R[j];
            }
            part[(dg * TB + tt) * 128 + e] = py;
        }
        __syncthreads();
        {
            const int tt = tid >> 5, e4 = (tid & 31) * 4; float y[4]; float ss = 0.f;
#pragma unroll
            for (int i = 0; i < 4; ++i) { y[i] = (part[(0 * TB + tt) * 128 + e4 + i] + part[(1 * TB + tt) * 128 + e4 + i]) + (part[(2 * TB + tt) * 128 + e4 + i] + part[(3 * TB + tt) * 128 + e4 + i]); ss += y[i] * y[i]; }
#pragma unroll
            for (int o = 1; o < 32; o <<= 1) ss += __shfl_xor(ss, o);
            const float r = 1.0f / sqrtf(ss * (1.f / 128.f) + EPS);
            const u32x2 zz = *(const u32x2*)(P + (tok0 + t0 + tt) * PW + zcol + e4);
            const float z0 = bf2f(zz.x & 0xffffu), z1 = bf2f(zz.x >> 16), z2 = bf2f(zz.y & 0xffffu), z3 = bf2f(zz.y >> 16);
            float g0 = 1.f, g1 = 1.f, g2 = 1.f, g3 = 1.f;
            if (GLA) { g0 = gng[e4]; g1 = gng[e4 + 1]; g2 = gng[e4 + 2]; g3 = gng[e4 + 3]; }
            u32x2 o; o.x = pk2(y[0] * r * g0 * z0, y[1] * r * g1 * z1); o.y = pk2(y[2] * r * g2 * z2, y[3] * r * g3 * z3);
            *(u32x2*)(MIX + (tok0 + t0 + tt) * DM + ocol + e4) = o;
        }
    }
}

#ifndef STREAM_MFMA
#define STREAM_MFMA 2
#endif
typedef short bf16x8 __attribute__((ext_vector_type(8)));
typedef float f32x16 __attribute__((ext_vector_type(16)));
#define MFMA16(a, b, c) __builtin_amdgcn_mfma_f32_16x16x32_bf16((a), (b), (c), 0, 0, 0)
#define MFMA32(a, b, c) __builtin_amdgcn_mfma_f32_32x32x16_bf16((a), (b), (c), 0, 0, 0)
__device__ __forceinline__ void unpack8(const u32x4 p, float (&f)[8]) {
    f[0] = bf2f(p.x & 0xffffu); f[1] = bf2f(p.x >> 16); f[2] = bf2f(p.y & 0xffffu); f[3] = bf2f(p.y >> 16);
    f[4] = bf2f(p.z & 0xffffu); f[5] = bf2f(p.z >> 16); f[6] = bf2f(p.w & 0xffffu); f[7] = bf2f(p.w >> 16);
}
__device__ __forceinline__ u32x4 pack8(const float (&f)[8]) { u32x4 o; o.x = pk2(f[0], f[1]); o.y = pk2(f[2], f[3]); o.z = pk2(f[4], f[5]); o.w = pk2(f[6], f[7]); return o; }

template <int DK, bool GLA>
__device__ __forceinline__ void stream_mfma(LAS unsigned char* lds, const bf16* P, const float* GLR, const float* Wg, const float* bg, const float* gng, bf16* MIX, int b, int h) {
    constexpr int QS = DK + 8, JS = 72, NQ = DK / 64, NR = DK / 64, KS = DK / 16, YS = 132;
    constexpr int SZ_Q = 64 * QS * 2, SZ_KHT = DK * JS * 2;
    constexpr int SZ_KK = (SZ_Q + SZ_KHT) > 64 * YS * 4 ? (SZ_Q + SZ_KHT) : 64 * YS * 4;
    constexpr int O_QT = 0, O_KT = SZ_Q, O_KHT = O_KT + SZ_Q, O_YB = O_KT, O_VT = O_KT + SZ_KK, O_ST = O_VT + 128 * JS * 2, O_RT = O_ST + 64 * JS * 2;
    constexpr int O_BT = O_RT + 128 * QS * 2, O_TOT = O_BT + (GLA ? 32768 : 0), O_END = O_TOT + (GLA ? 4096 : 0);
    static_assert(O_END <= LDS_BYTES, "stream LDS map");
    LAS bf16* Qt = (LAS bf16*)(lds + O_QT); LAS bf16* Kt = (LAS bf16*)(lds + O_KT); LAS bf16* KhT = (LAS bf16*)(lds + O_KHT);
    LAS bf16* VT = (LAS bf16*)(lds + O_VT); LAS bf16* St = (LAS bf16*)(lds + O_ST); LAS bf16* RT = (LAS bf16*)(lds + O_RT);
    LAS float* Yb = (LAS float*)(lds + O_YB); LAS float* BT = (LAS float*)(lds + O_BT); LAS float* TOT = (LAS float*)(lds + O_TOT);

    const int tid = threadIdx.x, lane = tid & 63, w = __builtin_amdgcn_readfirstlane(tid >> 6);
    const int l31 = lane & 31, hh = lane >> 5, l15 = lane & 15, q4 = lane >> 4;
    const int qcol = GLA ? 2048 + 64 * h : 128 * h, kcol = GLA ? 2304 + 64 * h : 512 + 128 * h;
    const int vcol = GLA ? 2560 + 128 * h : 1024 + 128 * h, zcol = GLA ? 3072 + 128 * h : 1536 + 128 * h, ocol = GLA ? 512 + 128 * h : 128 * h;
    const float lg2g = log2f(1.f - exp2f(-5.f - (float)h));
    const bf16* Pb = P + (size_t)b * SEQ * PW;
    const int qrow = GLA ? (tid >> 3) : (tid >> 4), qc8 = GLA ? (tid & 7) : (tid & 15);
    const int vrow = tid >> 4, vc8 = tid & 15;
    const int zi = tid >> 3, zseg = tid & 7;
    float wgr[16], bgr = 0.f;
    if (GLA) {
#pragma unroll
        for (int r = 0; r < 16; ++r) wgr[r] = Wg[r * 256 + 64 * h + lane];
        bgr = bg[64 * h + lane];
    }
    u32x4 pq[NQ], pk[NQ], pv[2], pz[2], zc[2];
    float la[8];
#define STREAM_LOAD(n) do { const bf16* base_ = Pb + (size_t)(n) * 64 * PW; \
        _Pragma("unroll") for (int i_ = 0; i_ < NQ; ++i_) { pq[i_] = *(const u32x4*)(base_ + (size_t)(qrow + 32 * i_) * PW + qcol + 8 * qc8); pk[i_] = *(const u32x4*)(base_ + (size_t)(qrow + 32 * i_) * PW + kcol + 8 * qc8); } \
        _Pragma("unroll") for (int i_ = 0; i_ < 2; ++i_) { pv[i_] = *(const u32x4*)(base_ + (size_t)(vrow + 32 * i_) * PW + vcol + 8 * vc8); pz[i_] = *(const u32x4*)(base_ + (size_t)zi * PW + zcol + 16 * zseg + 8 * i_); } } while (0)
#define GATE_PART1(n) do { const float* g_ = GLR + ((size_t)b * SEQ + 64 * (n) + 8 * w) * 16; float run_ = 0.f; \
        _Pragma("unroll") for (int t_ = 0; t_ < 8; ++t_) { float z_ = bgr; _Pragma("unroll") for (int r_ = 0; r_ < 16; ++r_) z_ += g_[t_ * 16 + r_] * wgr[r_]; \
            run_ += (fminf(z_, 0.f) - log1pf(__expf(-fabsf(z_)))) * (1.f / 16.f); la[t_] = run_; } \
        TOT[(((n) & 1) * 8 + w) * 64 + lane] = run_; } while (0)
#define GATE_PART2(n) do { float base_ = 0.f; for (int w_ = 0; w_ < w; ++w_) base_ += TOT[(((n) & 1) * 8 + w_) * 64 + lane]; \
        _Pragma("unroll") for (int t_ = 0; t_ < 8; ++t_) BT[((n) & 1) * 4096 + (8 * w + t_) * 64 + lane] = base_ + la[t_]; } while (0)

    __syncthreads();
    STREAM_LOAD(0);
    if (GLA) { GATE_PART1(0); __syncthreads(); GATE_PART2(0); }
    f32x16 R[NR];
#pragma unroll
    for (int t = 0; t < NR; ++t)
#pragma unroll
        for (int i = 0; i < 16; ++i) R[t][i] = 0.f;
    const int eb = w & 3;

    for (int n = 0; n < SEQ / 64; ++n) {
        __syncthreads();
        const LAS float* BTc = BT + (n & 1) * 4096;
#pragma unroll
        for (int i = 0; i < NQ; ++i) {
            const int row = qrow + 32 * i;
            float fq[8], fk[8], fh[8];
            unpack8(pq[i], fq); unpack8(pk[i], fk);
            if (GLA) {
                const f32x4 b0 = *(const LAS f32x4*)(BTc + row * 64 + 8 * qc8), b1 = *(const LAS f32x4*)(BTc + row * 64 + 8 * qc8 + 4);
                const f32x4 e0 = *(const LAS f32x4*)(BTc + 63 * 64 + 8 * qc8), e1 = *(const LAS f32x4*)(BTc + 63 * 64 + 8 * qc8 + 4);
#pragma unroll
                for (int e = 0; e < 8; ++e) { const float bb = e < 4 ? b0[e & 3] : b1[e & 3], bl = e < 4 ? e0[e & 3] : e1[e & 3];
                    fq[e] *= __expf(bb); fh[e] = fk[e] * __expf(bl - bb); fk[e] *= __expf(-bb); }
            } else {
                const float sq = exp2f((float)(row + 1) * lg2g), sk = exp2f(-(float)(row + 1) * lg2g), sh = exp2f((float)(63 - row) * lg2g);
#pragma unroll
                for (int e = 0; e < 8; ++e) { fq[e] *= sq; fh[e] = fk[e] * sh; fk[e] *= sk; }
            }
            *(LAS u32x4*)(Qt + row * QS + 8 * qc8) = pack8(fq);
            *(LAS u32x4*)(Kt + row * QS + 8 * qc8) = pack8(fk);
#pragma unroll
            for (int e = 0; e < 8; ++e) KhT[(8 * qc8 + e) * JS + row] = (bf16)f2bf(fh[e]);
        }
#pragma unroll
        for (int i = 0; i < 2; ++i) {
            const int row = vrow + 32 * i; const u32x4 p = pv[i];
            VT[(8 * vc8 + 0) * JS + row] = (bf16)(p.x & 0xffffu); VT[(8 * vc8 + 1) * JS + row] = (bf16)(p.x >> 16);
            VT[(8 * vc8 + 2) * JS + row] = (bf16)(p.y & 0xffffu); VT[(8 * vc8 + 3) * JS + row] = (bf16)(p.y >> 16);
            VT[(8 * vc8 + 4) * JS + row] = (bf16)(p.z & 0xffffu); VT[(8 * vc8 + 5) * JS + row] = (bf16)(p.z >> 16);
            VT[(8 * vc8 + 6) * JS + row] = (bf16)(p.w & 0xffffu); VT[(8 * vc8 + 7) * JS + row] = (bf16)(p.w >> 16);
        }
        zc[0] = pz[0]; zc[1] = pz[1];
#pragma unroll
        for (int t = 0; t < NR; ++t) {
            const int db = NR * (w >> 2) + t;
#pragma unroll
            for (int g = 0; g < 4; ++g) { u32x2 wv; wv.x = pk2(R[t][4 * g], R[t][4 * g + 1]); wv.y = pk2(R[t][4 * g + 2], R[t][4 * g + 3]);
                *(LAS u32x2*)(RT + (32 * eb + l31) * QS + 32 * db + 8 * g + 4 * hh) = wv; }
        }
        if (n + 1 < SEQ / 64) STREAM_LOAD(n + 1);
        __syncthreads();
        {
            const int ib = w & 3, jb0 = 2 * (w >> 2);
            pg8::f32x4 sacc[2] = {{0.f, 0.f, 0.f, 0.f}, {0.f, 0.f, 0.f, 0.f}};
#pragma unroll
            for (int s = 0; s < DK / 32; ++s) {
                const bf16x8 bq = *(const LAS bf16x8*)(Qt + (16 * ib + l15) * QS + 32 * s + 8 * q4);
#pragma unroll
                for (int t = 0; t < 2; ++t) { const bf16x8 ak = *(const LAS bf16x8*)(Kt + (16 * (jb0 + t) + l15) * QS + 32 * s + 8 * q4); sacc[t] = MFMA16(ak, bq, sacc[t]); }
            }
#pragma unroll
            for (int t = 0; t < 2; ++t) {
                const int i = 16 * ib + l15, j0 = 16 * (jb0 + t) + 4 * q4;
                u32x2 wv; wv.x = pk2(j0 <= i ? sacc[t][0] : 0.f, j0 + 1 <= i ? sacc[t][1] : 0.f); wv.y = pk2(j0 + 2 <= i ? sacc[t][2] : 0.f, j0 + 3 <= i ? sacc[t][3] : 0.f);
                *(LAS u32x2*)(St + i * JS + j0) = wv;
            }
        }
#pragma unroll
        for (int t = 0; t < NR; ++t) {
            const int db = NR * (w >> 2) + t;
            if (GLA) {
#pragma unroll
                for (int r = 0; r < 16; ++r) R[t][r] *= __expf(BTc[63 * 64 + 32 * db + (r & 3) + 8 * (r >> 2) + 4 * hh]);
            } else {
                const float a64 = exp2f(64.f * lg2g);
#pragma unroll
                for (int r = 0; r < 16; ++r) R[t][r] *= a64;
            }
#pragma unroll
            for (int s = 0; s < 4; ++s) {
                const bf16x8 a = *(const LAS bf16x8*)(KhT + (32 * db + l31) * JS + 16 * s + 8 * hh);
                const bf16x8 bv = *(const LAS bf16x8*)(VT + (32 * eb + l31) * JS + 16 * s + 8 * hh);
                R[t] = MFMA32(a, bv, R[t]);
            }
        }
        if (GLA) { if (n + 1 < SEQ / 64) GATE_PART1(n + 1); }
        __syncthreads();
        {
            const int ib = w >> 2;
            f32x16 y;
#pragma unroll
            for (int i = 0; i < 16; ++i) y[i] = 0.f;
#pragma unroll
            for (int s = 0; s < KS; ++s) {
                const bf16x8 a = *(const LAS bf16x8*)(RT + (32 * eb + l31) * QS + 16 * s + 8 * hh);
                const bf16x8 bq = *(const LAS bf16x8*)(Qt + (32 * ib + l31) * QS + 16 * s + 8 * hh);
                y = MFMA32(a, bq, y);
            }
#pragma unroll
            for (int s = 0; s < 4; ++s) {
                const bf16x8 a = *(const LAS bf16x8*)(VT + (32 * eb + l31) * JS + 16 * s + 8 * hh);
                const bf16x8 bs = *(const LAS bf16x8*)(St + (32 * ib + l31) * JS + 16 * s + 8 * hh);
                y = MFMA32(a, bs, y);
            }
#pragma unroll
            for (int g = 0; g < 4; ++g) { pg8::f32x4 o = {y[4 * g], y[4 * g + 1], y[4 * g + 2], y[4 * g + 3]}; *(LAS pg8::f32x4*)(Yb + (32 * ib + l31) * YS + 32 * eb + 8 * g + 4 * hh) = o; }
        }
        if (GLA) { if (n + 1 < SEQ / 64) GATE_PART2(n + 1); }
        __syncthreads();
        {
            float yv[16]; float ss = 0.f;
#pragma unroll
            for (int k = 0; k < 4; ++k) { const pg8::f32x4 t = *(const LAS pg8::f32x4*)(Yb + zi * YS + 16 * zseg + 4 * k); yv[4 * k] = t[0]; yv[4 * k + 1] = t[1]; yv[4 * k + 2] = t[2]; yv[4 * k + 3] = t[3]; ss += (t[0] * t[0] + t[1] * t[1]) + (t[2] * t[2] + t[3] * t[3]); }
            ss += __shfl_xor(ss, 1); ss += __shfl_xor(ss, 2); ss += __shfl_xor(ss, 4);
            const float r = 1.0f / sqrtf(ss * (1.f / 128.f) + EPS);
            float z0[8], z1[8]; unpack8(zc[0], z0); unpack8(zc[1], z1);
            float o0[8], o1[8];
#pragma unroll
            for (int e = 0; e < 8; ++e) {
                float g0 = r, g1 = r;
                if (GLA) { g0 *= gng[16 * zseg + e]; g1 *= gng[16 * zseg + 8 + e]; }
                o0[e] = yv[e] * g0 * z0[e]; o1[e] = yv[8 + e] * g1 * z1[e];
            }
            bf16* op = MIX + ((size_t)b * SEQ + 64 * n + zi) * DM + ocol + 16 * zseg;
            *(u32x4*)op = pack8(o0); *(u32x4*)(op + 8) = pack8(o1);
        }
    }
#undef STREAM_LOAD
#undef GATE_PART1
#undef GATE_PART2
}

__device__ __forceinline__ void phase_final(float* out, const float* final_gain) {
    const int tid = threadIdx.x, lane = tid & 63, wave = tid >> 6;
    const int gw = blockIdx.x * 8 + wave, NGW = gridDim.x * 8;
    f32x4 g[4];
#pragma unroll
    for (int j = 0; j < 4; ++j) g[j] = ((const f32x4*)final_gain)[lane + 64 * j];
    for (int m = gw; m < NT; m += NGW) {
        f32x4* xr = (f32x4*)(out + (size_t)m * DM) + lane;
        f32x4 v[4]; float ss = 0.f;
#pragma unroll
        for (int j = 0; j < 4; ++j) { v[j] = xr[64 * j]; ss += (v[j].x * v[j].x + v[j].y * v[j].y) + (v[j].z * v[j].z + v[j].w * v[j].w); }
        ss = wave_sum(ss);
        const float r = 1.0f / sqrtf(ss * (1.f / DM) + EPS);
#pragma unroll
        for (int j = 0; j < 4; ++j) xr[64 * j] = v[j] * r * g[j];
    }
}

struct Args { const float* in[11]; float* out; unsigned char* ws; int ph_lo, ph_hi; };
#ifndef ONE_LAUNCH
#define ONE_LAUNCH 1
#endif
constexpr int N_PHASES = 6;

template <bool COOP>
__global__ void __launch_bounds__(512, 2) fwd(Args a) {
    extern __shared__ __attribute__((aligned(16))) unsigned char lds_raw[];
    LAS unsigned char* lds = (LAS unsigned char*)lds_raw;
    const float* x = a.in[0]; const float* c = a.in[1]; const float* norm_gain = a.in[2]; const float* w_ada = a.in[3]; const float* b_ada = a.in[4];
    const float* w_in = a.in[5]; const float* w_gate = a.in[6]; const float* b_gate = a.in[7]; const float* gng = a.in[8]; const float* w_out = a.in[9]; const float* final_gain = a.in[10];
    unsigned char* ws = a.ws;
    float* MUL = (float*)(ws + WS_MUL); float* SHIFT = (float*)(ws + WS_SHIFT); float* GATE = (float*)(ws + WS_GATE);
    bf16* WIN = (bf16*)(ws + WS_WIN); bf16* WOUT = (bf16*)(ws + WS_WOUT); float* GLR = (float*)(ws + WS_GLR);
    bf16* H = (bf16*)(ws + WS_H); bf16* P = (bf16*)(ws + WS_P); bf16* MIX = (bf16*)(ws + WS_MIX);
    const int lo = a.ph_lo, hi = a.ph_hi;
#define IN(k) (lo <= (k) && (k) < hi)
#define SEAM(k) do { if (COOP) { if (IN(k) && IN((k) + 1)) cg::this_grid().sync(); } } while (0)
    if (IN(0)) phase_ada(lds, c, w_ada, b_ada, norm_gain, MUL, SHIFT, GATE);
    SEAM(0);
    if (IN(1)) phase_prep(lds, x, w_in, w_out, MUL, SHIFT, WIN, WOUT, H);
    SEAM(1);
    if (IN(2)) {
        pg8::Gemm g{H, WIN, NT, NPAD, DM}; pg8::StaticOrder S; S.init(NT, NPAD, (int)gridDim.x, (int)blockIdx.x);
        EpiP E{P, GLR};
        pg8::gemm_phase<EpiP, pg8::StaticOrder, true, true>(lds, g, S, E);
    }
    SEAM(2);
    if (IN(3)) {
        for (int s = blockIdx.x; s < 256; s += gridDim.x) {
            const int bh = s >> 1, b = bh >> 2, h = bh & 3;
#if STREAM_MFMA >= 2
            if (s & 1) stream_mfma<64, true>(lds, P, GLR, w_gate, b_gate, gng, MIX, b, h);
#else
            if (s & 1) stream_naive<64, true>(lds, P, GLR, w_gate, b_gate, gng, MIX, b, h);
#endif
#if STREAM_MFMA >= 1
            else stream_mfma<128, false>(lds, P, GLR, w_gate, b_gate, gng, MIX, b, h);
#else
            else stream_naive<128, false>(lds, P, GLR, w_gate, b_gate, gng, MIX, b, h);
#endif
        }
    }
    SEAM(3);
    if (IN(4)) {
        pg8::Gemm g{MIX, WOUT, NT, DM, DM}; pg8::StaticOrder S; S.init(NT, DM, (int)gridDim.x, (int)blockIdx.x);
        EpiOut E{x, GATE, a.out};
        pg8::gemm_phase<EpiOut, pg8::StaticOrder, true, true>(lds, g, S, E);
    }
    SEAM(4);
    if (IN(5)) phase_final(a.out, final_gain);
#undef IN
#undef SEAM
}

extern "C" void kernel_launch(void* const* d_in, const int* in_sizes, int n_in, void* d_out, int out_size, void* d_ws, size_t ws_size, hipStream_t stream) {
    static int grid = 0;
    if (grid == 0) {
        if (n_in != 11 || in_sizes[0] != NT * DM || out_size != NT * DM || ws_size < WS_END) { fprintf(stderr, "kernel_launch: unexpected shapes (n_in %d, in0 %d, out %d, ws %zu)\n", n_in, n_in > 0 ? in_sizes[0] : -1, out_size, ws_size); grid = -1; return; }
        int dev = 0, cus = 0, per_cu = 0;
        if (hipGetDevice(&dev) != hipSuccess || hipDeviceGetAttribute(&cus, hipDeviceAttributeMultiprocessorCount, dev) != hipSuccess) { grid = -1; return; }
        (void)hipFuncSetAttribute((const void*)fwd<true>, hipFuncAttributeMaxDynamicSharedMemorySize, LDS_BYTES);
        (void)hipFuncSetAttribute((const void*)fwd<false>, hipFuncAttributeMaxDynamicSharedMemorySize, LDS_BYTES);
        if (hipOccupancyMaxActiveBlocksPerMultiprocessor(&per_cu, (const void*)fwd<true>, 512, LDS_BYTES) != hipSuccess || per_cu < 1) { fprintf(stderr, "kernel_launch: occupancy query says %d blocks per CU\n", per_cu); per_cu = 1; }
        (void)hipGetLastError();
        grid = cus;
    }
    if (grid < 0) return;
    Args a{};
    for (int i = 0; i < 11; ++i) a.in[i] = (const float*)d_in[i];
    a.out = (float*)d_out; a.ws = (unsigned char*)d_ws;
#if ONE_LAUNCH
    a.ph_lo = 0; a.ph_hi = N_PHASES;
    void* args[] = {&a};
    hipError_t e = hipLaunchCooperativeKernel((const void*)fwd<true>, dim3(grid), dim3(512), args, LDS_BYTES, stream);
    if (e != hipSuccess) fprintf(stderr, "cooperative launch failed: %s (grid %d)\n", hipGetErrorString(e), grid);
#else
    for (int p = 0; p < N_PHASES; ++p) {
        a.ph_lo = p; a.ph_hi = p + 1;
        hipLaunchKernelGGL(fwd<false>, dim3(grid), dim3(512), LDS_BYTES, stream, a);
    }
#endif
}
```

```cpp
#include <hip/hip_runtime.h>
#include <hip/hip_cooperative_groups.h>
#include <cstdio>
#include <cstdint>
namespace cg = cooperative_groups;
namespace pg8 {
#define PG8_LAS __attribute__((address_space(3)))
typedef unsigned short bf16_t;
typedef short bf16x8 __attribute__((ext_vector_type(8)));
typedef float f32x4 __attribute__((ext_vector_type(4)));
typedef unsigned u32x4 __attribute__((ext_vector_type(4)));
constexpr int BM = 256, BK = 64, HALF = 128, HTB = HALF * BK * 2  , STAGE_BYTES = 8 * HTB, NXCD = 8, WGM = 8;

__host__ __device__ __forceinline__ int lds_byte(int r, int c) { const int st = (r >> 4) * 2 + (c >> 5), rr = r & 15, cc = c & 31, ob = rr * 64 + cc * 2; return st * 1024 + (ob ^ (((ob >> 9) & 1) << 5)); }
__host__ __device__ __forceinline__ void stage_rc(int b, int& R, int& C) { const int st = b / 1024, sb = b % 1024, swz = sb ^ (((sb >> 9) & 1) << 5); R = (st >> 1) * 16 + swz / 64; C = (st & 1) * 32 + (swz % 64) / 2; }
__host__ __device__ __forceinline__ int perm32(int rho) { const int n = rho >> 4, i = rho & 15; return 8 * (i >> 2) + 4 * n + (i & 3); }

struct Unit { int pm, pn; };
struct Gemm { const bf16_t* A; const bf16_t* Bt; int M, N, K; };

struct StaticOrder {
    int nM, nN, nwg, G, c;
    __host__ __device__ void init(int M, int N, int G_, int c_) { nM = M / BM; nN = N / BM; nwg = nM * nN; G = G_; c = c_; }
    __host__ __device__ bool next(int i, Unit& u) const {
        const long L = (long)i * G + c; if (L >= nwg) return false;
        int wgid = (int)L; { const int q = nwg / NXCD, r = nwg % NXCD, xcd = wgid % NXCD, off = wgid / NXCD; wgid = (xcd < r ? xcd * (q + 1) : r * (q + 1) + (xcd - r) * q) + off; }
        const int nig = WGM * nN, gid = wgid / nig, fm = gid * WGM, gsz = (nM - fm) < WGM ? (nM - fm) : WGM;
        u.pm = fm + ((wgid % nig) % gsz); u.pn = (wgid % nig) / gsz; return true;
    }
    __device__ __forceinline__ void a_ready(const Unit&) const {}
    __device__ __forceinline__ void done(const Unit&) const {}
};

__device__ __forceinline__ unsigned cvt_pk_bf16(float lo, float hi) { unsigned r; asm volatile("v_cvt_pk_bf16_f32 %0, %1, %2" : "=v"(r) : "v"(lo), "v"(hi)); return r; }
typedef float f32x2 __attribute__((ext_vector_type(2)));
__device__ __forceinline__ f32x2 gelu_pk(f32x2 v) {
    const f32x2 av = __builtin_elementwise_abs(v), d = av * 0.2316418882f + 1.0f;
    f32x2 t; t.x = __builtin_amdgcn_rcpf(d.x); t.y = __builtin_amdgcn_rcpf(d.y);
    f32x2 q = t * 0.5307027145f + (-0.7265760135f); q = q * t + 0.7107068705f; q = q * t + (-0.142248368f); q = q * t + 0.127414796f; q = q * t;
    const f32x2 s = (v * v) * (-0.72134752044f);
    f32x2 e; e.x = __builtin_amdgcn_exp2f(s.x); e.y = __builtin_amdgcn_exp2f(s.y);
    const f32x2 m = v * (q * e), r = v - m;
    f32x2 o; o.x = v.x < 0.f ? m.x : r.x; o.y = v.y < 0.f ? m.y : r.y; return o;
}

template <int ACT  > struct EpiBf16 {
    static constexpr bool PERM = true, AFTER_DRAIN = false; static_assert(ACT == 0 || ACT == 1, "EpiBf16: ACT is 0 (none) or 1 (gelu_pk)");
    bf16_t* O; int ldc; const float* bias; int split_cols; size_t split_stride; float scale0;
    __device__ __forceinline__ void operator()(const f32x4 (&acc)[2][2][4][2], const Unit& u, int wr, int wc, int fr, int fq) const {
        const int row0 = u.pm * BM + wr * 64 + fr; int colt = u.pn * BM; bf16_t* base = O;
        float sc = 1.f; if (split_cols) { const int t = colt / split_cols; base += (size_t)t * split_stride; colt -= t * split_cols; if (t == 0) sc = scale0; }
        const int col0 = colt + wc * 32 + 8 * fq, bcol0 = u.pn * BM + wc * 32 + 8 * fq;
        f32x4 bv[2][2];
#pragma unroll
        for (int bj = 0; bj < 2; ++bj)
#pragma unroll
            for (int n = 0; n < 2; ++n) bv[bj][n] = bias ? *(const f32x4*)(bias + bcol0 + bj * HALF + 4 * n) : (f32x4){0.f, 0.f, 0.f, 0.f};
#pragma unroll
        for (int ai = 0; ai < 2; ++ai)
#pragma unroll
            for (int m = 0; m < 4; ++m) { bf16_t* rowp = base + (size_t)(row0 + ai * HALF + m * 16) * ldc + col0;
#pragma unroll
                for (int bj = 0; bj < 2; ++bj) { f32x4 v0 = acc[ai][bj][m][0] + bv[bj][0], v1 = acc[ai][bj][m][1] + bv[bj][1];
                    if (ACT == 1) { f32x2 a = gelu_pk((f32x2){v0[0], v0[1]}), b = gelu_pk((f32x2){v0[2], v0[3]}), c = gelu_pk((f32x2){v1[0], v1[1]}), d = gelu_pk((f32x2){v1[2], v1[3]});
                        v0 = (f32x4){a.x, a.y, b.x, b.y}; v1 = (f32x4){c.x, c.y, d.x, d.y}; }
                    v0 = v0 * sc; v1 = v1 * sc; u32x4 w; w.x = cvt_pk_bf16(v0[0], v0[1]); w.y = cvt_pk_bf16(v0[2], v0[3]); w.z = cvt_pk_bf16(v1[0], v1[1]); w.w = cvt_pk_bf16(v1[2], v1[3]);
                    *(u32x4*)(rowp + bj * HALF) = w; } }
    }
};
template <class Epi, class Sched, bool ALIGN_EPI = false, bool SP2 = false>
__device__ __forceinline__ void gemm_phase(PG8_LAS unsigned char* lds, const Gemm g, const Sched& S, const Epi& E) {
    const int tid = threadIdx.x, wid = __builtin_amdgcn_readfirstlane(tid >> 6), lane = tid & 63, wr = wid >> 2, wc = wid & 3, fr = lane & 15, fq = lane >> 4;
    const int K = g.K, nt = K / BK;
    unsigned voffA[2], voffB[2];
#pragma unroll
    for (int i = 0; i < 2; ++i) { int R, C; stage_rc(tid * 16 + i * 8192, R, C); const int Rb = Epi::PERM ? ((R & ~31) + perm32(R & 31)) : R;
        voffA[i] = (unsigned)(R * K + C) * 2u; voffB[i] = (unsigned)(Rb * K + C) * 2u; }
    const size_t kstep = (size_t)(BK * 2);
    const size_t hstep = (size_t)HALF * K * 2;
    const size_t tstep = 2 * hstep;
    const unsigned ldsw = (unsigned)wid * 1024u;
    const int aoff = lds_byte(wr * 64 + fr, fq * 8), boff = lds_byte(wc * 32 + fr, fq * 8);
#define PG8_SA(b, h) (((b) * 2 + (h)) * HTB)
#define PG8_SB(b, h) ((4 + (b) * 2 + (h)) * HTB)
#define PG8_STAGE(bufoff, gbase, voff) do { _Pragma("unroll") for (int _i = 0; _i < 2; ++_i) \
        __builtin_amdgcn_global_load_lds((const unsigned*)((const char*)(gbase) + (voff)[_i]), (PG8_LAS unsigned*)(lds + (bufoff) + ldsw + _i * 8192), 16, 0, 0); } while (0)
#define PG8_LDA(dst, b, h) do { _Pragma("unroll") for (int m = 0; m < 4; ++m) _Pragma("unroll") for (int k = 0; k < 2; ++k) dst[m][k] = *(const PG8_LAS bf16x8*)(lds + PG8_SA(b, h) + aoff + m * 2048 + k * 1024); } while (0)
#define PG8_LDB(dst, b, h) do { _Pragma("unroll") for (int n = 0; n < 2; ++n) _Pragma("unroll") for (int k = 0; k < 2; ++k) dst[n][k] = *(const PG8_LAS bf16x8*)(lds + PG8_SB(b, h) + boff + n * 2048 + k * 1024); } while (0)
#define PG8_MMA(ai, bj, At, Bt) do { __builtin_amdgcn_s_setprio(1); _Pragma("unroll") for (int m = 0; m < 4; ++m) _Pragma("unroll") for (int n = 0; n < 2; ++n) _Pragma("unroll") for (int k = 0; k < 2; ++k) \
        acc[ai][bj][m][n] = __builtin_amdgcn_mfma_f32_16x16x32_bf16(Bt[n][k], At[m][k], acc[ai][bj][m][n], 0, 0, 0); __builtin_amdgcn_s_setprio(0); } while (0)
#define PG8_WAIT_V(n) asm volatile("s_waitcnt vmcnt(" #n ")" ::: "memory")
#define PG8_WAIT_L(n) asm volatile("s_waitcnt lgkmcnt(" #n ")" ::: "memory")
#define PG8_BAR __builtin_amdgcn_s_barrier()
#define PG8_SCHED __builtin_amdgcn_sched_barrier(0)
    Unit cur, nxt; int ui = 0;
    if (!S.next(0, cur)) return;
    f32x4 acc[2][2][4][2];
#pragma unroll
    for (int a = 0; a < 2; ++a)
#pragma unroll
        for (int b = 0; b < 2; ++b)
#pragma unroll
            for (int m = 0; m < 4; ++m)
#pragma unroll
                for (int n = 0; n < 2; ++n) acc[a][b][m][n] = (f32x4){0.f, 0.f, 0.f, 0.f};
    bf16x8 At[4][2], B0[2][2], B1[2][2];
    const char* cA = (const char*)g.A + (size_t)cur.pm * tstep; const char* cB = (const char*)g.Bt + (size_t)cur.pn * tstep;
    S.a_ready(cur);
    if constexpr (SP2) {
        PG8_STAGE(PG8_SB(0, 0), cB, voffB); PG8_STAGE(PG8_SB(0, 1), cB + hstep, voffB); PG8_STAGE(PG8_SA(0, 0), cA, voffA); PG8_STAGE(PG8_SA(0, 1), cA + hstep, voffA);
        if (wr == 1) PG8_BAR;
        PG8_WAIT_V(2); PG8_BAR;
        PG8_STAGE(PG8_SB(1, 0), cB + kstep, voffB); PG8_STAGE(PG8_SA(1, 0), cA + kstep, voffA); PG8_STAGE(PG8_SB(1, 1), cB + hstep + kstep, voffB);
        PG8_WAIT_V(6); PG8_BAR;
    } else {
        PG8_STAGE(PG8_SB(0, 0), cB, voffB); PG8_STAGE(PG8_SA(0, 0), cA, voffA); PG8_STAGE(PG8_SB(0, 1), cB + hstep, voffB); PG8_STAGE(PG8_SA(0, 1), cA + hstep, voffA);
        if (wr == 1) PG8_BAR;
        PG8_WAIT_V(4); PG8_BAR;
        PG8_STAGE(PG8_SB(1, 0), cB + kstep, voffB); PG8_STAGE(PG8_SA(1, 0), cA + kstep, voffA); PG8_STAGE(PG8_SB(1, 1), cB + hstep + kstep, voffB);
        PG8_WAIT_V(6); PG8_BAR;
    }
    for (;;) {
        const bool has_next = S.next(ui + 1, nxt);
        const char* nA = has_next ? (const char*)g.A + (size_t)nxt.pm * tstep : cA; const char* nB = has_next ? (const char*)g.Bt + (size_t)nxt.pn * tstep : cB;
        for (int t = 0; t < nt; t += 2) {
            const bool last = (t == nt - 2);
            const char* a1 = cA + (size_t)(t + 1) * kstep;
            const char* a2 = last ? nA : cA + (size_t)(t + 2) * kstep; const char* b2 = last ? nB : cB + (size_t)(t + 2) * kstep;
            const char* a3 = a2 + kstep; const char* b3 = b2 + kstep;
            if (last && has_next) S.a_ready(nxt);
            if constexpr (SP2) {
            PG8_LDB(B0, 0, 0); PG8_LDB(B1, 0, 1); PG8_SCHED; PG8_LDA(At, 0, 0); PG8_STAGE(PG8_SA(1, 1), a1 + hstep, voffA);
            PG8_WAIT_V(8); PG8_WAIT_L(0); PG8_BAR; PG8_MMA(0, 0, At, B0); PG8_MMA(0, 1, At, B1); PG8_BAR; PG8_SCHED;
            PG8_LDA(At, 0, 1); PG8_STAGE(PG8_SB(0, 0), b2, voffB); PG8_STAGE(PG8_SB(0, 1), b2 + hstep, voffB); PG8_STAGE(PG8_SA(0, 0), a2, voffA);
            PG8_WAIT_V(8); PG8_WAIT_L(0); PG8_BAR; PG8_MMA(1, 0, At, B0); PG8_MMA(1, 1, At, B1); PG8_BAR; PG8_SCHED;
            PG8_LDB(B0, 1, 0); PG8_LDB(B1, 1, 1); PG8_SCHED; PG8_LDA(At, 1, 0); PG8_STAGE(PG8_SA(0, 1), a2 + hstep, voffA);
            PG8_WAIT_V(8); PG8_WAIT_L(0); PG8_BAR; PG8_MMA(0, 0, At, B0); PG8_MMA(0, 1, At, B1); PG8_BAR; PG8_SCHED;
            PG8_LDA(At, 1, 1); PG8_STAGE(PG8_SB(1, 0), b3, voffB); PG8_STAGE(PG8_SB(1, 1), b3 + hstep, voffB); PG8_STAGE(PG8_SA(1, 0), a3, voffA);
            PG8_WAIT_V(8); PG8_WAIT_L(0); PG8_BAR; PG8_MMA(1, 0, At, B0); PG8_MMA(1, 1, At, B1); PG8_BAR; PG8_SCHED;
            } else {
            PG8_LDB(B0, 0, 0); PG8_SCHED; PG8_LDA(At, 0, 0); PG8_STAGE(PG8_SA(1, 1), a1 + hstep, voffA);
            PG8_WAIT_L(8); PG8_BAR; PG8_WAIT_L(0); PG8_MMA(0, 0, At, B0); PG8_BAR; PG8_SCHED;
            PG8_LDB(B1, 0, 1); PG8_STAGE(PG8_SB(0, 0), b2, voffB);
            PG8_BAR; PG8_WAIT_L(0); PG8_MMA(0, 1, At, B1); PG8_BAR;
            PG8_LDA(At, 0, 1); PG8_STAGE(PG8_SA(0, 0), a2, voffA);
            PG8_BAR; PG8_WAIT_L(0); PG8_MMA(1, 0, At, B0); PG8_BAR; PG8_SCHED;
            PG8_STAGE(PG8_SB(0, 1), b2 + hstep, voffB);
            PG8_WAIT_V(6); PG8_BAR; PG8_MMA(1, 1, At, B1); PG8_BAR;
            PG8_LDB(B0, 1, 0); PG8_SCHED; PG8_LDA(At, 1, 0); PG8_STAGE(PG8_SA(0, 1), a2 + hstep, voffA);
            PG8_WAIT_L(8); PG8_BAR; PG8_WAIT_L(0); PG8_MMA(0, 0, At, B0); PG8_BAR; PG8_SCHED;
            PG8_LDB(B1, 1, 1); PG8_STAGE(PG8_SB(1, 0), b3, voffB);
            PG8_BAR; PG8_WAIT_L(0); PG8_MMA(0, 1, At, B1); PG8_BAR;
            PG8_LDA(At, 1, 1); PG8_STAGE(PG8_SA(1, 0), a3, voffA);
            PG8_BAR; PG8_WAIT_L(0); PG8_MMA(1, 0, At, B0); PG8_BAR; PG8_SCHED;
            PG8_STAGE(PG8_SB(1, 1), b3 + hstep, voffB);
            PG8_WAIT_V(6); PG8_BAR; PG8_MMA(1, 1, At, B1); PG8_BAR;
            }
        }
        if constexpr (ALIGN_EPI) { if (wr == 0) PG8_BAR; }
        if constexpr (!Epi::AFTER_DRAIN) { E(acc, cur, wr, wc, fr, fq); S.done(cur); }
        if (!has_next) break;
#pragma unroll
        for (int a = 0; a < 2; ++a)
#pragma unroll
            for (int b = 0; b < 2; ++b)
#pragma unroll
                for (int m = 0; m < 4; ++m)
#pragma unroll
                    for (int n = 0; n < 2; ++n) acc[a][b][m][n] = (f32x4){0.f, 0.f, 0.f, 0.f};
        cur = nxt; cA = nA; cB = nB; ++ui;
        if constexpr (ALIGN_EPI) { if (wr == 1) PG8_BAR; }
    }
    PG8_WAIT_V(0);
    if constexpr (!ALIGN_EPI) { if (wr == 0) PG8_BAR; }
    PG8_BAR;
    if constexpr (Epi::AFTER_DRAIN) { E.fused(acc, cur, wr, wc, fr, fq, lds, wid, lane); S.done(cur); }
#undef PG8_SA
#undef PG8_SB
#undef PG8_STAGE
#undef PG8_LDA
#undef PG8_LDB
#undef PG8_MMA
#undef PG8_WAIT_V
#undef PG8_WAIT_L
#undef PG8_BAR
#undef PG8_SCHED
}
}

constexpr int NB = 32, SEQ = 2048, DM = 1024, NT = NB * SEQ;
constexpr int DIN = 3600, NPAD = 3840, PW = 3840;
constexpr float EPS = 1e-6f;
constexpr size_t MiB = 1u << 20;
constexpr size_t WS_MUL = 1 * MiB, WS_SHIFT = WS_MUL + 131072, WS_GATE = WS_SHIFT + 131072;
constexpr size_t WS_WIN = 2 * MiB;
constexpr size_t WS_WOUT = 10 * MiB;
constexpr size_t WS_H = 16 * MiB;
constexpr size_t WS_P = 144 * MiB;
constexpr size_t WS_MIX = 640 * MiB;
constexpr size_t WS_END = 768 * MiB;
constexpr int LDS_BYTES = 147456;

#define LAS __attribute__((address_space(3)))
typedef unsigned short bf16;
typedef float f32x4 __attribute__((ext_vector_type(4)));
typedef unsigned u32x4 __attribute__((ext_vector_type(4)));
typedef unsigned u32x2 __attribute__((ext_vector_type(2)));

__device__ __forceinline__ unsigned f2bf(float f) { unsigned u = __builtin_bit_cast(unsigned, f); return (u + 0x7fffu + ((u >> 16) & 1u)) >> 16; }
__device__ __forceinline__ unsigned pk2(float lo, float hi) { return f2bf(lo) | (f2bf(hi) << 16); }
__device__ __forceinline__ float bf2f(unsigned v) { return __builtin_bit_cast(float, v << 16); }
__device__ __forceinline__ float wave_sum(float v) {
#pragma unroll
    for (int o = 1; o < 64; o <<= 1) v += __shfl_xor(v, o);
    return v;
}
__device__ __forceinline__ float silu_f(float v) { return v / (1.f + __expf(-v)); }

struct EpiP {
    static constexpr bool PERM = true, AFTER_DRAIN = false;
    bf16* P; const float* bgate;
    __device__ __forceinline__ void operator()(const pg8::f32x4 (&acc)[2][2][4][2], const pg8::Unit& u, int wr, int wc, int fr, int fq) const {
        const int pn = u.pn;
        const int row0 = u.pm * 256 + wr * 64 + fr;
        const int cl = wc * 32 + 8 * fq;
        if (pn < 4) {
            const float sc = (pn >= 2) ? 0.08838834764831845f : 1.0f;
            float frev[4];
#pragma unroll
            for (int j = 0; j < 4; ++j) frev[j] = exp2f(-(float)(16 * wc + 4 * fq + j) * 0.20762050593046014f) * 0.15915494309189535f;
#pragma unroll
            for (int ai = 0; ai < 2; ++ai)
#pragma unroll
                for (int m = 0; m < 4; ++m) {
                    const int row = row0 + ai * 128 + m * 16;
                    const float pos = (float)(row & (SEQ - 1));
                    float sn[4], cs[4];
#pragma unroll
                    for (int j = 0; j < 4; ++j) { const float rev = __builtin_amdgcn_fractf(pos * frev[j]); sn[j] = __builtin_amdgcn_sinf(rev) * sc; cs[j] = __builtin_amdgcn_cosf(rev) * sc; }
#pragma unroll
                    for (int bj = 0; bj < 2; ++bj) {
                        const pg8::f32x4 v0 = acc[ai][bj][m][0], v1 = acc[ai][bj][m][1];
                        u32x4 w;
                        w.x = pk2(v0[0] * cs[0] - v0[1] * sn[0], v0[0] * sn[0] + v0[1] * cs[0]);
                        w.y = pk2(v0[2] * cs[1] - v0[3] * sn[1], v0[2] * sn[1] + v0[3] * cs[1]);
                        w.z = pk2(v1[0] * cs[2] - v1[1] * sn[2], v1[0] * sn[2] + v1[1] * cs[2]);
                        w.w = pk2(v1[2] * cs[3] - v1[3] * sn[3], v1[2] * sn[3] + v1[3] * cs[3]);
                        *(u32x4*)(P + (size_t)row * PW + pn * 256 + bj * 128 + cl) = w;
                    }
                }
        } else if (pn < 14) {
            const bool act = (pn == 6 || pn == 7 || pn == 12 || pn == 13);
            const float sc = (pn == 8) ? 0.125f : 1.0f;
#pragma unroll
            for (int ai = 0; ai < 2; ++ai)
#pragma unroll
                for (int m = 0; m < 4; ++m) {
                    const int row = row0 + ai * 128 + m * 16;
#pragma unroll
                    for (int bj = 0; bj < 2; ++bj) {
                        pg8::f32x4 v0 = acc[ai][bj][m][0] * sc, v1 = acc[ai][bj][m][1] * sc;
                        if (act) {
#pragma unroll
                            for (int i = 0; i < 4; ++i) { v0[i] = silu_f(v0[i]); v1[i] = silu_f(v1[i]); }
                        }
                        u32x4 w; w.x = pk2(v0[0], v0[1]); w.y = pk2(v0[2], v0[3]); w.z = pk2(v1[0], v1[1]); w.w = pk2(v1[2], v1[3]);
                        *(u32x4*)(P + (size_t)row * PW + pn * 256 + bj * 128 + cl) = w;
                    }
                }
        } else {
            pg8::f32x4 bv[2][2];
#pragma unroll
            for (int bj = 0; bj < 2; ++bj) { bv[bj][0] = *(const pg8::f32x4*)(bgate + bj * 128 + cl); bv[bj][1] = *(const pg8::f32x4*)(bgate + bj * 128 + cl + 4); }
#pragma unroll
            for (int ai = 0; ai < 2; ++ai)
#pragma unroll
                for (int m = 0; m < 4; ++m) {
                    const int row = row0 + ai * 128 + m * 16;
#pragma unroll
                    for (int bj = 0; bj < 2; ++bj) {
                        pg8::f32x4 v0 = acc[ai][bj][m][0] + bv[bj][0], v1 = acc[ai][bj][m][1] + bv[bj][1];
#pragma unroll
                        for (int i = 0; i < 4; ++i) { v0[i] = (fminf(v0[i], 0.f) - log1pf(__expf(-fabsf(v0[i])))) * (1.f / 16.f); v1[i] = (fminf(v1[i], 0.f) - log1pf(__expf(-fabsf(v1[i])))) * (1.f / 16.f); }
                        u32x4 w; w.x = pk2(v0[0], v0[1]); w.y = pk2(v0[2], v0[3]); w.z = pk2(v1[0], v1[1]); w.w = pk2(v1[2], v1[3]);
                        *(u32x4*)(P + (size_t)row * PW + pn * 256 + bj * 128 + cl) = w;
                    }
                }
        }
    }
};
struct EpiOut {
    static constexpr bool PERM = false, AFTER_DRAIN = false;
    const float* x; const float* gate; float* out;
    __device__ __forceinline__ void operator()(const pg8::f32x4 (&acc)[2][2][4][2], const pg8::Unit& u, int wr, int wc, int fr, int fq) const {
        const int row0 = u.pm * 256 + wr * 64 + fr, col0 = u.pn * 256 + wc * 32 + 4 * fq, b = u.pm >> 3;
        pg8::f32x4 g[2][2];
#pragma unroll
        for (int bj = 0; bj < 2; ++bj)
#pragma unroll
            for (int n = 0; n < 2; ++n) g[bj][n] = *(const pg8::f32x4*)(gate + b * DM + col0 + bj * 128 + n * 16);
#pragma unroll
        for (int ai = 0; ai < 2; ++ai)
#pragma unroll
            for (int m = 0; m < 4; ++m) {
                const size_t ro = (size_t)(row0 + ai * 128 + m * 16) * DM + col0;
#pragma unroll
                for (int bj = 0; bj < 2; ++bj)
#pragma unroll
                    for (int n = 0; n < 2; ++n) {
                        const size_t off = ro + bj * 128 + n * 16;
                        const pg8::f32x4 xv = *(const pg8::f32x4*)(x + off);
                        *(pg8::f32x4*)(out + off) = xv + g[bj][n] * acc[ai][bj][m][n];
                    }
            }
    }
};

__device__ __forceinline__ void phase_ada(LAS unsigned char* lds, const float* c, const float* w_ada, const float* b_ada, const float* norm_gain, float* MUL, float* SHIFT, float* GATE) {
    const int tid = threadIdx.x, lane = tid & 63, wave = tid >> 6;
    LAS float* sc = (LAS float*)lds;
    LAS float* red = (LAS float*)(lds + 131072);
    for (int i = tid; i < NB * DM; i += 512) sc[i] = silu_f(c[i]);
    __syncthreads();
    const int kg = tid >> 4, cs = tid & 15;
    for (int cb = blockIdx.x; cb < 256; cb += gridDim.x) {
        float acc[32];
#pragma unroll
        for (int b = 0; b < 32; ++b) acc[b] = 0.f;
        if (cs < 12) {
            const float* wp = w_ada + cb * 12 + cs;
            for (int k = kg; k < DM; k += 32) {
                const float w = wp[(size_t)k * 3072];
#pragma unroll
                for (int b = 0; b < 32; ++b) acc[b] += sc[b * 1024 + k] * w;
            }
        }
#pragma unroll
        for (int b = 0; b < 32; ++b) { acc[b] += __shfl_xor(acc[b], 16); acc[b] += __shfl_xor(acc[b], 32); }
        if (lane < 16) {
#pragma unroll
            for (int b = 0; b < 32; ++b) red[(wave * 16 + cs) * 32 + b] = acc[b];
        }
        __syncthreads();
        if (tid < 384) {
            const int cs2 = tid >> 5, b = tid & 31; float v = 0.f;
#pragma unroll
            for (int w = 0; w < 8; ++w) v += red[(w * 16 + cs2) * 32 + b];
            const int n = cb * 12 + cs2; v += b_ada[n];
            if (n < 1024) SHIFT[b * 1024 + n] = v;
            else if (n < 2048) MUL[b * 1024 + n - 1024] = norm_gain[n - 1024] * (1.f + v);
            else GATE[b * 1024 + n - 2048] = v;
        }
        __syncthreads();
    }
}

__device__ __forceinline__ int src_col(int n) {
    if (n >= 3584) return -2;
    if (n < 1024) { const int pc = n & 127; return (n & ~127) + (pc >> 1) + ((pc & 1) << 6); }
    return n;
}
__device__ __forceinline__ void transpose_item(const float* W, int N, bool permute, const float* Wg, bf16* WT, LAS float* scr, int item, int nblk, int lane) {
    const int kb = item / nblk, nb = item % nblk, k0 = 64 * kb, n0 = 32 * nb;
    const int src = permute ? src_col(n0 + (lane & 31)) : n0 + (lane & 31);
    if (src == -2) {
        float wg[16];
#pragma unroll
        for (int r = 0; r < 16; ++r) wg[r] = Wg[r * 256 + n0 + (lane & 31) - 3584];
        for (int i = 0; i < 32; ++i) { const int kk = 2 * i + (lane >> 5); const float* wr = W + (size_t)(k0 + kk) * N + 3584; float v = 0.f;
#pragma unroll
            for (int r = 0; r < 16; ++r) v += wr[r] * wg[r];
            scr[kk * 33 + (lane & 31)] = v; }
    } else {
#pragma unroll 8
        for (int i = 0; i < 32; ++i) { const int kk = 2 * i + (lane >> 5); scr[kk * 33 + (lane & 31)] = (src >= 0) ? W[(size_t)(k0 + kk) * N + src] : 0.f; }
    }
    asm volatile("s_waitcnt lgkmcnt(0)" ::: "memory");
    const int c = lane & 7;
#pragma unroll
    for (int j = 0; j < 4; ++j) {
        const int n = (lane >> 3) + 8 * j; const LAS float* s = scr + (8 * c) * 33 + n;
        u32x4 o; o.x = pk2(s[0 * 33], s[1 * 33]); o.y = pk2(s[2 * 33], s[3 * 33]); o.z = pk2(s[4 * 33], s[5 * 33]); o.w = pk2(s[6 * 33], s[7 * 33]);
        *(u32x4*)(WT + (size_t)(n0 + n) * 1024 + k0 + 8 * c) = o;
    }
    asm volatile("s_waitcnt lgkmcnt(0)" ::: "memory");
}
__device__ __forceinline__ void phase_prep(LAS unsigned char* lds, const float* x, const float* w_in, const float* w_out, const float* w_gate, const float* MUL, const float* SHIFT, bf16* WIN, bf16* WOUT, bf16* H) {
    const int tid = threadIdx.x, lane = tid & 63, wave = tid >> 6;
    LAS float* scr = (LAS float*)(lds + wave * 16384);
    const int gw = blockIdx.x * 8 + wave, NGW = gridDim.x * 8;
    constexpr int I_IN = 16 * (NPAD / 32), I_OUT = 16 * (DM / 32);
    for (int it = gw; it < I_IN + I_OUT; it += NGW) {
        if (it < I_IN) transpose_item(w_in, DIN, true, w_gate, WIN, scr, it, NPAD / 32, lane);
        else transpose_item(w_out, DM, false, w_gate, WOUT, scr, it - I_IN, DM / 32, lane);
    }
    for (int m = gw; m < NT; m += NGW) {
        const f32x4* xr = (const f32x4*)(x + (size_t)m * DM) + lane;
        f32x4 v[4]; float ss = 0.f;
#pragma unroll
        for (int j = 0; j < 4; ++j) { v[j] = xr[64 * j]; ss += (v[j].x * v[j].x + v[j].y * v[j].y) + (v[j].z * v[j].z + v[j].w * v[j].w); }
        ss = wave_sum(ss);
        const float r = 1.0f / sqrtf(ss * (1.f / DM) + EPS);
        const int b = m >> 11;
        const f32x4* mr = (const f32x4*)(MUL + b * DM) + lane; const f32x4* sr = (const f32x4*)(SHIFT + b * DM) + lane;
        unsigned long long* o8 = (unsigned long long*)(H + (size_t)m * DM) + lane;
#pragma unroll
        for (int j = 0; j < 4; ++j) {
            const f32x4 hv = v[j] * r * mr[64 * j] + sr[64 * j];
            o8[64 * j] = (unsigned long long)pk2(hv.x, hv.y) | ((unsigned long long)pk2(hv.z, hv.w) << 32);
        }
    }
}

#ifndef STREAM_MFMA
#define STREAM_MFMA 2
#endif
typedef short bf16x8 __attribute__((ext_vector_type(8)));
typedef float f32x16 __attribute__((ext_vector_type(16)));
#define MFMA16(a, b, c) __builtin_amdgcn_mfma_f32_16x16x32_bf16((a), (b), (c), 0, 0, 0)
#define MFMA32(a, b, c) __builtin_amdgcn_mfma_f32_32x32x16_bf16((a), (b), (c), 0, 0, 0)
__device__ __forceinline__ void unpack8(const u32x4 p, float (&f)[8]) {
    f[0] = bf2f(p.x & 0xffffu); f[1] = bf2f(p.x >> 16); f[2] = bf2f(p.y & 0xffffu); f[3] = bf2f(p.y >> 16);
    f[4] = bf2f(p.z & 0xffffu); f[5] = bf2f(p.z >> 16); f[6] = bf2f(p.w & 0xffffu); f[7] = bf2f(p.w >> 16);
}
__device__ __forceinline__ u32x4 pack8(const float (&f)[8]) { u32x4 o; o.x = pk2(f[0], f[1]); o.y = pk2(f[2], f[3]); o.z = pk2(f[4], f[5]); o.w = pk2(f[6], f[7]); return o; }

typedef short s16x4 __attribute__((ext_vector_type(4)));
__device__ __forceinline__ bf16x8 tr_frag(const LAS unsigned char* p, int off, int rsb) {
    const s16x4 lo = __builtin_amdgcn_ds_read_tr16_b64_v4i16((LAS s16x4*)(p + off));
    const s16x4 hi = __builtin_amdgcn_ds_read_tr16_b64_v4i16((LAS s16x4*)(p + off + 4 * rsb));
    return __builtin_shufflevector(lo, hi, 0, 1, 2, 3, 4, 5, 6, 7);
}
template <int DK, bool GLA>
__device__ __forceinline__ void stream_mfma(LAS unsigned char* lds, const bf16* P, const float* gng, bf16* MIX, int b, int h) {
    constexpr int QS = DK + 8, JS = 72, NQ = DK / 64, NR = DK / 64, KS = DK / 16, YS = 132;
    constexpr int RSB = 320;
    constexpr int SZ_Q = 64 * QS * 2, SZ_KHT = 64 * RSB;
    constexpr int SZ_KK = (SZ_Q + SZ_KHT) > 64 * YS * 4 ? (SZ_Q + SZ_KHT) : 64 * YS * 4;
    constexpr int O_QT = 0, O_KT = SZ_Q, O_KHT = O_KT + SZ_Q, O_YB = O_KT, O_VT = O_KT + SZ_KK, O_ST = O_VT + 64 * RSB, O_RT = O_ST + 64 * JS * 2;
    constexpr int O_BT = O_RT + 128 * QS * 2, O_TOT = O_BT + (GLA ? 32768 : 0), O_END = O_TOT + (GLA ? 4096 : 0);
    static_assert(O_END <= LDS_BYTES, "stream LDS map");
    LAS bf16* Qt = (LAS bf16*)(lds + O_QT); LAS bf16* Kt = (LAS bf16*)(lds + O_KT); LAS unsigned char* Kh = lds + O_KHT;
    LAS unsigned char* Vr = lds + O_VT; LAS bf16* St = (LAS bf16*)(lds + O_ST); LAS bf16* RT = (LAS bf16*)(lds + O_RT);
    LAS float* Yb = (LAS float*)(lds + O_YB); LAS float* BT = (LAS float*)(lds + O_BT); LAS float* TOT = (LAS float*)(lds + O_TOT);

    const int tid = threadIdx.x, lane = tid & 63, w = __builtin_amdgcn_readfirstlane(tid >> 6);
    const int l31 = lane & 31, hh = lane >> 5, l15 = lane & 15, q4 = lane >> 4;
    const int qcol = GLA ? 2048 + 64 * h : 128 * h, kcol = GLA ? 2304 + 64 * h : 512 + 128 * h;
    const int vcol = GLA ? 2560 + 128 * h : 1024 + 128 * h, zcol = GLA ? 3072 + 128 * h : 1536 + 128 * h, ocol = GLA ? 512 + 128 * h : 128 * h;
    const int trb = (8 * hh + (l15 >> 2)) * RSB + (16 * (q4 & 1) + 4 * (lane & 3)) * 2;
    const float lg2g = log2f(1.f - exp2f(-5.f - (float)h));
    const bf16* Pb = P + (size_t)b * SEQ * PW;
    const int qrow = GLA ? (tid >> 3) : (tid >> 4), qc8 = GLA ? (tid & 7) : (tid & 15);
    const int vrow = tid >> 4, vc8 = tid & 15;
    const int zi = tid >> 3, zseg = tid & 7;
    bf16 lgr[8];
    u32x4 pq[NQ], pk[NQ], pv[2], pz[2], zc[2];
    float la[8];
#define STREAM_LOAD(n) do { const bf16* base_ = Pb + (size_t)(n) * 64 * PW; \
        _Pragma("unroll") for (int i_ = 0; i_ < NQ; ++i_) { pq[i_] = *(const u32x4*)(base_ + (size_t)(qrow + 32 * i_) * PW + qcol + 8 * qc8); pk[i_] = *(const u32x4*)(base_ + (size_t)(qrow + 32 * i_) * PW + kcol + 8 * qc8); } \
        _Pragma("unroll") for (int i_ = 0; i_ < 2; ++i_) { pv[i_] = *(const u32x4*)(base_ + (size_t)(vrow + 32 * i_) * PW + vcol + 8 * vc8); pz[i_] = *(const u32x4*)(base_ + (size_t)zi * PW + zcol + 16 * zseg + 8 * i_); } \
        if (GLA) { _Pragma("unroll") for (int t_ = 0; t_ < 8; ++t_) lgr[t_] = base_[(size_t)(8 * w + t_) * PW + 3584 + 64 * h + lane]; } } while (0)
#define GATE_PART1(n) do { float run_ = 0.f; \
        _Pragma("unroll") for (int t_ = 0; t_ < 8; ++t_) { run_ += bf2f(lgr[t_]); la[t_] = run_; } \
        TOT[(((n) & 1) * 8 + w) * 64 + lane] = run_; } while (0)
#define GATE_PART2(n) do { float base_ = 0.f; for (int w_ = 0; w_ < w; ++w_) base_ += TOT[(((n) & 1) * 8 + w_) * 64 + lane]; \
        _Pragma("unroll") for (int t_ = 0; t_ < 8; ++t_) BT[((n) & 1) * 4096 + (8 * w + t_) * 64 + lane] = base_ + la[t_]; } while (0)

    __syncthreads();
    STREAM_LOAD(0);
    if (GLA) { GATE_PART1(0); __syncthreads(); GATE_PART2(0); }
    f32x16 R[NR];
#pragma unroll
    for (int t = 0; t < NR; ++t)
#pragma unroll
        for (int i = 0; i < 16; ++i) R[t][i] = 0.f;
    const int eb = w & 3;

    for (int n = 0; n < SEQ / 64; ++n) {
        __syncthreads();
        const LAS float* BTc = BT + (n & 1) * 4096;
#pragma unroll
        for (int i = 0; i < NQ; ++i) {
            const int row = qrow + 32 * i;
            float fq[8], fk[8], fh[8];
            unpack8(pq[i], fq); unpack8(pk[i], fk);
            if (GLA) {
                const f32x4 b0 = *(const LAS f32x4*)(BTc + row * 64 + 8 * qc8), b1 = *(const LAS f32x4*)(BTc + row * 64 + 8 * qc8 + 4);
                const f32x4 e0 = *(const LAS f32x4*)(BTc + 63 * 64 + 8 * qc8), e1 = *(const LAS f32x4*)(BTc + 63 * 64 + 8 * qc8 + 4);
#pragma unroll
                for (int e = 0; e < 8; ++e) { const float bb = e < 4 ? b0[e & 3] : b1[e & 3], bl = e < 4 ? e0[e & 3] : e1[e & 3];
                    fq[e] *= __expf(bb); fh[e] = fk[e] * __expf(bl - bb); fk[e] *= __expf(-bb); }
            } else {
                const float sq = exp2f((float)(row + 1) * lg2g), sk = exp2f(-(float)(row + 1) * lg2g), sh = exp2f((float)(63 - row) * lg2g);
#pragma unroll
                for (int e = 0; e < 8; ++e) { fq[e] *= sq; fh[e] = fk[e] * sh; fk[e] *= sk; }
            }
            *(LAS u32x4*)(Qt + row * QS + 8 * qc8) = pack8(fq);
            *(LAS u32x4*)(Kt + row * QS + 8 * qc8) = pack8(fk);
            *(LAS u32x4*)(Kh + row * RSB + 16 * qc8) = pack8(fh);
        }
#pragma unroll
        for (int i = 0; i < 2; ++i) {
            *(LAS u32x4*)(Vr + (vrow + 32 * i) * RSB + 16 * vc8) = pv[i];
        }
        zc[0] = pz[0]; zc[1] = pz[1];
#pragma unroll
        for (int t = 0; t < NR; ++t) {
            const int db = NR * (w >> 2) + t;
#pragma unroll
            for (int g = 0; g < 4; ++g) { u32x2 wv; wv.x = pk2(R[t][4 * g], R[t][4 * g + 1]); wv.y = pk2(R[t][4 * g + 2], R[t][4 * g + 3]);
                *(LAS u32x2*)(RT + (32 * eb + l31) * QS + 32 * db + 8 * g + 4 * hh) = wv; }
        }
        if (n + 1 < SEQ / 64) STREAM_LOAD(n + 1);
        __syncthreads();
        {
            const int ib = w & 3, jb0 = 2 * (w >> 2);
            pg8::f32x4 sacc[2] = {{0.f, 0.f, 0.f, 0.f}, {0.f, 0.f, 0.f, 0.f}};
#pragma unroll
            for (int s = 0; s < DK / 32; ++s) {
                const bf16x8 bq = *(const LAS bf16x8*)(Qt + (16 * ib + l15) * QS + 32 * s + 8 * q4);
#pragma unroll
                for (int t = 0; t < 2; ++t) { const bf16x8 ak = *(const LAS bf16x8*)(Kt + (16 * (jb0 + t) + l15) * QS + 32 * s + 8 * q4); sacc[t] = MFMA16(ak, bq, sacc[t]); }
            }
#pragma unroll
            for (int t = 0; t < 2; ++t) {
                const int i = 16 * ib + l15, j0 = 16 * (jb0 + t) + 4 * q4;
                u32x2 wv; wv.x = pk2(j0 <= i ? sacc[t][0] : 0.f, j0 + 1 <= i ? sacc[t][1] : 0.f); wv.y = pk2(j0 + 2 <= i ? sacc[t][2] : 0.f, j0 + 3 <= i ? sacc[t][3] : 0.f);
                *(LAS u32x2*)(St + i * JS + j0) = wv;
            }
        }
        bf16x8 vfrag[4];
#pragma unroll
        for (int s = 0; s < 4; ++s) vfrag[s] = tr_frag(Vr + trb + 64 * eb, 16 * s * RSB, RSB);
#pragma unroll
        for (int t = 0; t < NR; ++t) {
            const int db = NR * (w >> 2) + t;
            if (GLA) {
#pragma unroll
                for (int r = 0; r < 16; ++r) R[t][r] *= __expf(BTc[63 * 64 + 32 * db + (r & 3) + 8 * (r >> 2) + 4 * hh]);
            } else {
                const float a64 = exp2f(64.f * lg2g);
#pragma unroll
                for (int r = 0; r < 16; ++r) R[t][r] *= a64;
            }
#pragma unroll
            for (int s = 0; s < 4; ++s) R[t] = MFMA32(tr_frag(Kh + trb + 64 * db, 16 * s * RSB, RSB), vfrag[s], R[t]);
        }
        if (GLA) { if (n + 1 < SEQ / 64) GATE_PART1(n + 1); }
        __syncthreads();
        {
            const int ib = w >> 2;
            f32x16 y;
#pragma unroll
            for (int i = 0; i < 16; ++i) y[i] = 0.f;
#pragma unroll
            for (int s = 0; s < KS; ++s) {
                const bf16x8 a = *(const LAS bf16x8*)(RT + (32 * eb + l31) * QS + 16 * s + 8 * hh);
                const bf16x8 bq = *(const LAS bf16x8*)(Qt + (32 * ib + l31) * QS + 16 * s + 8 * hh);
                y = MFMA32(a, bq, y);
            }
#pragma unroll
            for (int s = 0; s < 4; ++s) {
                const bf16x8 bs = *(const LAS bf16x8*)(St + (32 * ib + l31) * JS + 16 * s + 8 * hh);
                y = MFMA32(vfrag[s], bs, y);
            }
#pragma unroll
            for (int g = 0; g < 4; ++g) { pg8::f32x4 o = {y[4 * g], y[4 * g + 1], y[4 * g + 2], y[4 * g + 3]}; *(LAS pg8::f32x4*)(Yb + (32 * ib + l31) * YS + 32 * eb + 8 * g + 4 * hh) = o; }
        }
        if (GLA) { if (n + 1 < SEQ / 64) GATE_PART2(n + 1); }
        __syncthreads();
        {
            float yv[16]; float ss = 0.f;
#pragma unroll
            for (int k = 0; k < 4; ++k) { const pg8::f32x4 t = *(const LAS pg8::f32x4*)(Yb + zi * YS + 16 * zseg + 4 * k); yv[4 * k] = t[0]; yv[4 * k + 1] = t[1]; yv[4 * k + 2] = t[2]; yv[4 * k + 3] = t[3]; ss += (t[0] * t[0] + t[1] * t[1]) + (t[2] * t[2] + t[3] * t[3]); }
            ss += __shfl_xor(ss, 1); ss += __shfl_xor(ss, 2); ss += __shfl_xor(ss, 4);
            const float r = 1.0f / sqrtf(ss * (1.f / 128.f) + EPS);
            float z0[8], z1[8]; unpack8(zc[0], z0); unpack8(zc[1], z1);
            float o0[8], o1[8];
#pragma unroll
            for (int e = 0; e < 8; ++e) {
                float g0 = r, g1 = r;
                if (GLA) { g0 *= gng[16 * zseg + e]; g1 *= gng[16 * zseg + 8 + e]; }
                o0[e] = yv[e] * g0 * z0[e]; o1[e] = yv[8 + e] * g1 * z1[e];
            }
            bf16* op = MIX + ((size_t)b * SEQ + 64 * n + zi) * DM + ocol + 16 * zseg;
            *(u32x4*)op = pack8(o0); *(u32x4*)(op + 8) = pack8(o1);
        }
    }
#undef STREAM_LOAD
#undef GATE_PART1
#undef GATE_PART2
}

__device__ __forceinline__ void phase_final(float* out, const float* final_gain) {
    const int tid = threadIdx.x, lane = tid & 63, wave = tid >> 6;
    const int gw = blockIdx.x * 8 + wave, NGW = gridDim.x * 8;
    f32x4 g[4];
#pragma unroll
    for (int j = 0; j < 4; ++j) g[j] = ((const f32x4*)final_gain)[lane + 64 * j];
    for (int m = gw; m < NT; m += NGW) {
        f32x4* xr = (f32x4*)(out + (size_t)m * DM) + lane;
        f32x4 v[4]; float ss = 0.f;
#pragma unroll
        for (int j = 0; j < 4; ++j) { v[j] = xr[64 * j]; ss += (v[j].x * v[j].x + v[j].y * v[j].y) + (v[j].z * v[j].z + v[j].w * v[j].w); }
        ss = wave_sum(ss);
        const float r = 1.0f / sqrtf(ss * (1.f / DM) + EPS);
#pragma unroll
        for (int j = 0; j < 4; ++j) xr[64 * j] = v[j] * r * g[j];
    }
}

struct Args { const float* in[11]; float* out; unsigned char* ws; int ph_lo, ph_hi; };
#ifndef ONE_LAUNCH
#define ONE_LAUNCH 1
#endif
constexpr int N_PHASES = 6;
#ifndef REP2
#define REP2 1
#endif
#ifndef REP3
#define REP3 1
#endif
#ifndef REP4
#define REP4 1
#endif

template <bool COOP>
__global__ void __launch_bounds__(512, 2) fwd(Args a) {
    extern __shared__ __attribute__((aligned(16))) unsigned char lds_raw[];
    LAS unsigned char* lds = (LAS unsigned char*)lds_raw;
    const float* x = a.in[0]; const float* c = a.in[1]; const float* norm_gain = a.in[2]; const float* w_ada = a.in[3]; const float* b_ada = a.in[4];
    const float* w_in = a.in[5]; const float* w_gate = a.in[6]; const float* b_gate = a.in[7]; const float* gng = a.in[8]; const float* w_out = a.in[9]; const float* final_gain = a.in[10];
    unsigned char* ws = a.ws;
    float* MUL = (float*)(ws + WS_MUL); float* SHIFT = (float*)(ws + WS_SHIFT); float* GATE = (float*)(ws + WS_GATE);
    bf16* WIN = (bf16*)(ws + WS_WIN); bf16* WOUT = (bf16*)(ws + WS_WOUT);
    bf16* H = (bf16*)(ws + WS_H); bf16* P = (bf16*)(ws + WS_P); bf16* MIX = (bf16*)(ws + WS_MIX);
    const int lo = a.ph_lo, hi = a.ph_hi;
#define IN(k) (lo <= (k) && (k) < hi)
#define SEAM(k) do { if (COOP) { if (IN(k) && IN((k) + 1)) cg::this_grid().sync(); } } while (0)
    if (IN(0)) phase_ada(lds, c, w_ada, b_ada, norm_gain, MUL, SHIFT, GATE);
    SEAM(0);
    if (IN(1)) phase_prep(lds, x, w_in, w_out, w_gate, MUL, SHIFT, WIN, WOUT, H);
    SEAM(1);
#define PH2 \
    if (IN(2)) { \
        pg8::Gemm g{H, WIN, NT, NPAD, DM}; pg8::StaticOrder S; S.init(NT, NPAD, (int)gridDim.x, (int)blockIdx.x); \
        EpiP E{P, b_gate}; \
        pg8::gemm_phase<EpiP, pg8::StaticOrder, true, true>(lds, g, S, E); \
    }
    PH2
    if (REP2 > 1) { if (COOP) cg::this_grid().sync(); PH2 }
    SEAM(2);
    for (int rep = 0; rep < REP3; ++rep) { if (rep) { if (COOP) cg::this_grid().sync(); }
    if (IN(3)) {
        for (int s = blockIdx.x; s < 256; s += gridDim.x) {
            const int bh = s >> 1, b = bh >> 2, h = bh & 3;
            if (s & 1) stream_mfma<64, true>(lds, P, gng, MIX, b, h);
            else stream_mfma<128, false>(lds, P, gng, MIX, b, h);
        }
    } }
    SEAM(3);
#define PH4 \
    if (IN(4)) { \
        pg8::Gemm g{MIX, WOUT, NT, DM, DM}; pg8::StaticOrder S; S.init(NT, DM, (int)gridDim.x, (int)blockIdx.x); \
        EpiOut E{x, GATE, a.out}; \
        pg8::gemm_phase<EpiOut, pg8::StaticOrder, true, true>(lds, g, S, E); \
    }
    PH4
    if (REP4 > 1) { if (COOP) cg::this_grid().sync(); PH4 }
    SEAM(4);
    if (IN(5)) phase_final(a.out, final_gain);
#undef IN
#undef SEAM
}

extern "C" void kernel_launch(void* const* d_in, const int* in_sizes, int n_in, void* d_out, int out_size, void* d_ws, size_t ws_size, hipStream_t stream) {
    static int grid = 0;
    if (grid == 0) {
        if (n_in != 11 || in_sizes[0] != NT * DM || out_size != NT * DM || ws_size < WS_END) { fprintf(stderr, "kernel_launch: unexpected shapes (n_in %d, in0 %d, out %d, ws %zu)\n", n_in, n_in > 0 ? in_sizes[0] : -1, out_size, ws_size); grid = -1; return; }
        int dev = 0, cus = 0, per_cu = 0;
        if (hipGetDevice(&dev) != hipSuccess || hipDeviceGetAttribute(&cus, hipDeviceAttributeMultiprocessorCount, dev) != hipSuccess) { grid = -1; return; }
        (void)hipFuncSetAttribute((const void*)fwd<true>, hipFuncAttributeMaxDynamicSharedMemorySize, LDS_BYTES);
        (void)hipFuncSetAttribute((const void*)fwd<false>, hipFuncAttributeMaxDynamicSharedMemorySize, LDS_BYTES);
        if (hipOccupancyMaxActiveBlocksPerMultiprocessor(&per_cu, (const void*)fwd<true>, 512, LDS_BYTES) != hipSuccess || per_cu < 1) { fprintf(stderr, "kernel_launch: occupancy query says %d blocks per CU\n", per_cu); per_cu = 1; }
        (void)hipGetLastError();
        grid = cus;
    }
    if (grid < 0) return;
    Args a{};
    for (int i = 0; i < 11; ++i) a.in[i] = (const float*)d_in[i];
    a.out = (float*)d_out; a.ws = (unsigned char*)d_ws;
#if ONE_LAUNCH
    a.ph_lo = 0; a.ph_hi = N_PHASES;
    void* args[] = {&a};
    hipError_t e = hipLaunchCooperativeKernel((const void*)fwd<true>, dim3(grid), dim3(512), args, LDS_BYTES, stream);
    if (e != hipSuccess) fprintf(stderr, "cooperative launch failed: %s (grid %d)\n", hipGetErrorString(e), grid);
#else
    for (int p = 0; p < N_PHASES; ++p) {
        a.ph_lo = p; a.ph_hi = p + 1;
        hipLaunchKernelGGL(fwd<false>, dim3(grid), dim3(512), LDS_BYTES, stream, a);
    }
#endif
}
```

```cpp
#include <hip/hip_runtime.h>
#include <hip/hip_cooperative_groups.h>
#include <cstdio>
#include <cstdint>
namespace cg = cooperative_groups;
namespace pg8 {
#define PG8_LAS __attribute__((address_space(3)))
typedef unsigned short bf16_t;
typedef short bf16x8 __attribute__((ext_vector_type(8)));
typedef float f32x4 __attribute__((ext_vector_type(4)));
typedef unsigned u32x4 __attribute__((ext_vector_type(4)));
constexpr int BM = 256, BK = 64, HALF = 128, HTB = HALF * BK * 2  , STAGE_BYTES = 8 * HTB, NXCD = 8, WGM = 8;

__host__ __device__ __forceinline__ int lds_byte(int r, int c) { const int st = (r >> 4) * 2 + (c >> 5), rr = r & 15, cc = c & 31, ob = rr * 64 + cc * 2; return st * 1024 + (ob ^ (((ob >> 9) & 1) << 5)); }
__host__ __device__ __forceinline__ void stage_rc(int b, int& R, int& C) { const int st = b / 1024, sb = b % 1024, swz = sb ^ (((sb >> 9) & 1) << 5); R = (st >> 1) * 16 + swz / 64; C = (st & 1) * 32 + (swz % 64) / 2; }
__host__ __device__ __forceinline__ int perm32(int rho) { const int n = rho >> 4, i = rho & 15; return 8 * (i >> 2) + 4 * n + (i & 3); }

struct Unit { int pm, pn; };
struct Gemm { const bf16_t* A; const bf16_t* Bt; int M, N, K; };

struct StaticOrder {
    int nM, nN, nwg, G, c;
    __host__ __device__ void init(int M, int N, int G_, int c_) { nM = M / BM; nN = N / BM; nwg = nM * nN; G = G_; c = c_; }
    __host__ __device__ bool next(int i, Unit& u) const {
        const long L = (long)i * G + c; if (L >= nwg) return false;
        int wgid = (int)L; { const int q = nwg / NXCD, r = nwg % NXCD, xcd = wgid % NXCD, off = wgid / NXCD; wgid = (xcd < r ? xcd * (q + 1) : r * (q + 1) + (xcd - r) * q) + off; }
        const int nig = WGM * nN, gid = wgid / nig, fm = gid * WGM, gsz = (nM - fm) < WGM ? (nM - fm) : WGM;
        u.pm = fm + ((wgid % nig) % gsz); u.pn = (wgid % nig) / gsz; return true;
    }
    __device__ __forceinline__ void a_ready(const Unit&) const {}
    __device__ __forceinline__ void done(const Unit&) const {}
};

__device__ __forceinline__ unsigned cvt_pk_bf16(float lo, float hi) { unsigned r; asm volatile("v_cvt_pk_bf16_f32 %0, %1, %2" : "=v"(r) : "v"(lo), "v"(hi)); return r; }
typedef float f32x2 __attribute__((ext_vector_type(2)));
__device__ __forceinline__ f32x2 gelu_pk(f32x2 v) {
    const f32x2 av = __builtin_elementwise_abs(v), d = av * 0.2316418882f + 1.0f;
    f32x2 t; t.x = __builtin_amdgcn_rcpf(d.x); t.y = __builtin_amdgcn_rcpf(d.y);
    f32x2 q = t * 0.5307027145f + (-0.7265760135f); q = q * t + 0.7107068705f; q = q * t + (-0.142248368f); q = q * t + 0.127414796f; q = q * t;
    const f32x2 s = (v * v) * (-0.72134752044f);
    f32x2 e; e.x = __builtin_amdgcn_exp2f(s.x); e.y = __builtin_amdgcn_exp2f(s.y);
    const f32x2 m = v * (q * e), r = v - m;
    f32x2 o; o.x = v.x < 0.f ? m.x : r.x; o.y = v.y < 0.f ? m.y : r.y; return o;
}

template <int ACT  > struct EpiBf16 {
    static constexpr bool PERM = true, AFTER_DRAIN = false; static_assert(ACT == 0 || ACT == 1, "EpiBf16: ACT is 0 (none) or 1 (gelu_pk)");
    bf16_t* O; int ldc; const float* bias; int split_cols; size_t split_stride; float scale0;
    __device__ __forceinline__ void operator()(const f32x4 (&acc)[2][2][4][2], const Unit& u, int wr, int wc, int fr, int fq) const {
        const int row0 = u.pm * BM + wr * 64 + fr; int colt = u.pn * BM; bf16_t* base = O;
        float sc = 1.f; if (split_cols) { const int t = colt / split_cols; base += (size_t)t * split_stride; colt -= t * split_cols; if (t == 0) sc = scale0; }
        const int col0 = colt + wc * 32 + 8 * fq, bcol0 = u.pn * BM + wc * 32 + 8 * fq;
        f32x4 bv[2][2];
#pragma unroll
        for (int bj = 0; bj < 2; ++bj)
#pragma unroll
            for (int n = 0; n < 2; ++n) bv[bj][n] = bias ? *(const f32x4*)(bias + bcol0 + bj * HALF + 4 * n) : (f32x4){0.f, 0.f, 0.f, 0.f};
#pragma unroll
        for (int ai = 0; ai < 2; ++ai)
#pragma unroll
            for (int m = 0; m < 4; ++m) { bf16_t* rowp = base + (size_t)(row0 + ai * HALF + m * 16) * ldc + col0;
#pragma unroll
                for (int bj = 0; bj < 2; ++bj) { f32x4 v0 = acc[ai][bj][m][0] + bv[bj][0], v1 = acc[ai][bj][m][1] + bv[bj][1];
                    if (ACT == 1) { f32x2 a = gelu_pk((f32x2){v0[0], v0[1]}), b = gelu_pk((f32x2){v0[2], v0[3]}), c = gelu_pk((f32x2){v1[0], v1[1]}), d = gelu_pk((f32x2){v1[2], v1[3]});
                        v0 = (f32x4){a.x, a.y, b.x, b.y}; v1 = (f32x4){c.x, c.y, d.x, d.y}; }
                    v0 = v0 * sc; v1 = v1 * sc; u32x4 w; w.x = cvt_pk_bf16(v0[0], v0[1]); w.y = cvt_pk_bf16(v0[2], v0[3]); w.z = cvt_pk_bf16(v1[0], v1[1]); w.w = cvt_pk_bf16(v1[2], v1[3]);
                    *(u32x4*)(rowp + bj * HALF) = w; } }
    }
};
template <class Epi, class Sched, bool ALIGN_EPI = false, bool SP2 = false>
__device__ __forceinline__ void gemm_phase(PG8_LAS unsigned char* lds, const Gemm g, const Sched& S, const Epi& E) {
    const int tid = threadIdx.x, wid = __builtin_amdgcn_readfirstlane(tid >> 6), lane = tid & 63, wr = wid >> 2, wc = wid & 3, fr = lane & 15, fq = lane >> 4;
    const int K = g.K, nt = K / BK;
    unsigned voffA[2], voffB[2];
#pragma unroll
    for (int i = 0; i < 2; ++i) { int R, C; stage_rc(tid * 16 + i * 8192, R, C); const int Rb = Epi::PERM ? ((R & ~31) + perm32(R & 31)) : R;
        voffA[i] = (unsigned)(R * K + C) * 2u; voffB[i] = (unsigned)(Rb * K + C) * 2u; }
    const size_t kstep = (size_t)(BK * 2);
    const size_t hstep = (size_t)HALF * K * 2;
    const size_t tstep = 2 * hstep;
    const unsigned ldsw = (unsigned)wid * 1024u;
    const int aoff = lds_byte(wr * 64 + fr, fq * 8), boff = lds_byte(wc * 32 + fr, fq * 8);
#define PG8_SA(b, h) (((b) * 2 + (h)) * HTB)
#define PG8_SB(b, h) ((4 + (b) * 2 + (h)) * HTB)
#define PG8_STAGE(bufoff, gbase, voff) do { _Pragma("unroll") for (int _i = 0; _i < 2; ++_i) \
        __builtin_amdgcn_global_load_lds((const unsigned*)((const char*)(gbase) + (voff)[_i]), (PG8_LAS unsigned*)(lds + (bufoff) + ldsw + _i * 8192), 16, 0, 0); } while (0)
#define PG8_LDA(dst, b, h) do { _Pragma("unroll") for (int m = 0; m < 4; ++m) _Pragma("unroll") for (int k = 0; k < 2; ++k) dst[m][k] = *(const PG8_LAS bf16x8*)(lds + PG8_SA(b, h) + aoff + m * 2048 + k * 1024); } while (0)
#define PG8_LDB(dst, b, h) do { _Pragma("unroll") for (int n = 0; n < 2; ++n) _Pragma("unroll") for (int k = 0; k < 2; ++k) dst[n][k] = *(const PG8_LAS bf16x8*)(lds + PG8_SB(b, h) + boff + n * 2048 + k * 1024); } while (0)
#define PG8_MMA(ai, bj, At, Bt) do { __builtin_amdgcn_s_setprio(1); _Pragma("unroll") for (int m = 0; m < 4; ++m) _Pragma("unroll") for (int n = 0; n < 2; ++n) _Pragma("unroll") for (int k = 0; k < 2; ++k) \
        acc[ai][bj][m][n] = __builtin_amdgcn_mfma_f32_16x16x32_bf16(Bt[n][k], At[m][k], acc[ai][bj][m][n], 0, 0, 0); __builtin_amdgcn_s_setprio(0); } while (0)
#define PG8_WAIT_V(n) asm volatile("s_waitcnt vmcnt(" #n ")" ::: "memory")
#define PG8_WAIT_L(n) asm volatile("s_waitcnt lgkmcnt(" #n ")" ::: "memory")
#define PG8_BAR __builtin_amdgcn_s_barrier()
#define PG8_SCHED __builtin_amdgcn_sched_barrier(0)
    Unit cur, nxt; int ui = 0;
    if (!S.next(0, cur)) return;
    f32x4 acc[2][2][4][2];
#pragma unroll
    for (int a = 0; a < 2; ++a)
#pragma unroll
        for (int b = 0; b < 2; ++b)
#pragma unroll
            for (int m = 0; m < 4; ++m)
#pragma unroll
                for (int n = 0; n < 2; ++n) acc[a][b][m][n] = (f32x4){0.f, 0.f, 0.f, 0.f};
    bf16x8 At[4][2], B0[2][2], B1[2][2];
    const char* cA = (const char*)g.A + (size_t)cur.pm * tstep; const char* cB = (const char*)g.Bt + (size_t)cur.pn * tstep;
    S.a_ready(cur);
    if constexpr (SP2) {
        PG8_STAGE(PG8_SB(0, 0), cB, voffB); PG8_STAGE(PG8_SB(0, 1), cB + hstep, voffB); PG8_STAGE(PG8_SA(0, 0), cA, voffA); PG8_STAGE(PG8_SA(0, 1), cA + hstep, voffA);
        if (wr == 1) PG8_BAR;
        PG8_WAIT_V(2); PG8_BAR;
        PG8_STAGE(PG8_SB(1, 0), cB + kstep, voffB); PG8_STAGE(PG8_SA(1, 0), cA + kstep, voffA); PG8_STAGE(PG8_SB(1, 1), cB + hstep + kstep, voffB);
        PG8_WAIT_V(6); PG8_BAR;
    } else {
        PG8_STAGE(PG8_SB(0, 0), cB, voffB); PG8_STAGE(PG8_SA(0, 0), cA, voffA); PG8_STAGE(PG8_SB(0, 1), cB + hstep, voffB); PG8_STAGE(PG8_SA(0, 1), cA + hstep, voffA);
        if (wr == 1) PG8_BAR;
        PG8_WAIT_V(4); PG8_BAR;
        PG8_STAGE(PG8_SB(1, 0), cB + kstep, voffB); PG8_STAGE(PG8_SA(1, 0), cA + kstep, voffA); PG8_STAGE(PG8_SB(1, 1), cB + hstep + kstep, voffB);
        PG8_WAIT_V(6); PG8_BAR;
    }
    for (;;) {
        const bool has_next = S.next(ui + 1, nxt);
        const char* nA = has_next ? (const char*)g.A + (size_t)nxt.pm * tstep : cA; const char* nB = has_next ? (const char*)g.Bt + (size_t)nxt.pn * tstep : cB;
        for (int t = 0; t < nt; t += 2) {
            const bool last = (t == nt - 2);
            const char* a1 = cA + (size_t)(t + 1) * kstep;
            const char* a2 = last ? nA : cA + (size_t)(t + 2) * kstep; const char* b2 = last ? nB : cB + (size_t)(t + 2) * kstep;
            const char* a3 = a2 + kstep; const char* b3 = b2 + kstep;
            if (last && has_next) S.a_ready(nxt);
            if constexpr (SP2) {
            PG8_LDB(B0, 0, 0); PG8_LDB(B1, 0, 1); PG8_SCHED; PG8_LDA(At, 0, 0); PG8_STAGE(PG8_SA(1, 1), a1 + hstep, voffA);
            PG8_WAIT_V(8); PG8_WAIT_L(0); PG8_BAR; PG8_MMA(0, 0, At, B0); PG8_MMA(0, 1, At, B1); PG8_BAR; PG8_SCHED;
            PG8_LDA(At, 0, 1); PG8_STAGE(PG8_SB(0, 0), b2, voffB); PG8_STAGE(PG8_SB(0, 1), b2 + hstep, voffB); PG8_STAGE(PG8_SA(0, 0), a2, voffA);
            PG8_WAIT_V(8); PG8_WAIT_L(0); PG8_BAR; PG8_MMA(1, 0, At, B0); PG8_MMA(1, 1, At, B1); PG8_BAR; PG8_SCHED;
            PG8_LDB(B0, 1, 0); PG8_LDB(B1, 1, 1); PG8_SCHED; PG8_LDA(At, 1, 0); PG8_STAGE(PG8_SA(0, 1), a2 + hstep, voffA);
            PG8_WAIT_V(8); PG8_WAIT_L(0); PG8_BAR; PG8_MMA(0, 0, At, B0); PG8_MMA(0, 1, At, B1); PG8_BAR; PG8_SCHED;
            PG8_LDA(At, 1, 1); PG8_STAGE(PG8_SB(1, 0), b3, voffB); PG8_STAGE(PG8_SB(1, 1), b3 + hstep, voffB); PG8_STAGE(PG8_SA(1, 0), a3, voffA);
            PG8_WAIT_V(8); PG8_WAIT_L(0); PG8_BAR; PG8_MMA(1, 0, At, B0); PG8_MMA(1, 1, At, B1); PG8_BAR; PG8_SCHED;
            } else {
            PG8_LDB(B0, 0, 0); PG8_SCHED; PG8_LDA(At, 0, 0); PG8_STAGE(PG8_SA(1, 1), a1 + hstep, voffA);
            PG8_WAIT_L(8); PG8_BAR; PG8_WAIT_L(0); PG8_MMA(0, 0, At, B0); PG8_BAR; PG8_SCHED;
            PG8_LDB(B1, 0, 1); PG8_STAGE(PG8_SB(0, 0), b2, voffB);
            PG8_BAR; PG8_WAIT_L(0); PG8_MMA(0, 1, At, B1); PG8_BAR;
            PG8_LDA(At, 0, 1); PG8_STAGE(PG8_SA(0, 0), a2, voffA);
            PG8_BAR; PG8_WAIT_L(0); PG8_MMA(1, 0, At, B0); PG8_BAR; PG8_SCHED;
            PG8_STAGE(PG8_SB(0, 1), b2 + hstep, voffB);
            PG8_WAIT_V(6); PG8_BAR; PG8_MMA(1, 1, At, B1); PG8_BAR;
            PG8_LDB(B0, 1, 0); PG8_SCHED; PG8_LDA(At, 1, 0); PG8_STAGE(PG8_SA(0, 1), a2 + hstep, voffA);
            PG8_WAIT_L(8); PG8_BAR; PG8_WAIT_L(0); PG8_MMA(0, 0, At, B0); PG8_BAR; PG8_SCHED;
            PG8_LDB(B1, 1, 1); PG8_STAGE(PG8_SB(1, 0), b3, voffB);
            PG8_BAR; PG8_WAIT_L(0); PG8_MMA(0, 1, At, B1); PG8_BAR;
            PG8_LDA(At, 1, 1); PG8_STAGE(PG8_SA(1, 0), a3, voffA);
            PG8_BAR; PG8_WAIT_L(0); PG8_MMA(1, 0, At, B0); PG8_BAR; PG8_SCHED;
            PG8_STAGE(PG8_SB(1, 1), b3 + hstep, voffB);
            PG8_WAIT_V(6); PG8_BAR; PG8_MMA(1, 1, At, B1); PG8_BAR;
            }
        }
        if constexpr (ALIGN_EPI) { if (wr == 0) PG8_BAR; }
        if constexpr (!Epi::AFTER_DRAIN) { E(acc, cur, wr, wc, fr, fq); S.done(cur); }
        if (!has_next) break;
#pragma unroll
        for (int a = 0; a < 2; ++a)
#pragma unroll
            for (int b = 0; b < 2; ++b)
#pragma unroll
                for (int m = 0; m < 4; ++m)
#pragma unroll
                    for (int n = 0; n < 2; ++n) acc[a][b][m][n] = (f32x4){0.f, 0.f, 0.f, 0.f};
        cur = nxt; cA = nA; cB = nB; ++ui;
        if constexpr (ALIGN_EPI) { if (wr == 1) PG8_BAR; }
    }
    PG8_WAIT_V(0);
    if constexpr (!ALIGN_EPI) { if (wr == 0) PG8_BAR; }
    PG8_BAR;
    if constexpr (Epi::AFTER_DRAIN) { E.fused(acc, cur, wr, wc, fr, fq, lds, wid, lane); S.done(cur); }
#undef PG8_SA
#undef PG8_SB
#undef PG8_STAGE
#undef PG8_LDA
#undef PG8_LDB
#undef PG8_MMA
#undef PG8_WAIT_V
#undef PG8_WAIT_L
#undef PG8_BAR
#undef PG8_SCHED
}
}

constexpr int NB = 32, SEQ = 2048, DM = 1024, NT = NB * SEQ;
constexpr int DIN = 3600, NPAD = 3840, PW = 3840;
constexpr float EPS = 1e-6f;
constexpr size_t MiB = 1u << 20;
constexpr size_t WS_MUL = 1 * MiB, WS_SHIFT = WS_MUL + 131072, WS_GATE = WS_SHIFT + 131072;
constexpr size_t WS_WIN = 2 * MiB;
constexpr size_t WS_WOUT = 10 * MiB;
constexpr size_t WS_H = 16 * MiB;
constexpr size_t WS_P = 144 * MiB;
constexpr size_t WS_MIX = 640 * MiB;
constexpr size_t WS_END = 768 * MiB;
constexpr int LDS_MISC = 147456, LDS_BYTES = LDS_MISC + 256;
constexpr size_t WS_CTL = 0, CTL_BYTES = 16384;

#define LAS __attribute__((address_space(3)))
typedef unsigned short bf16;
typedef float f32x4 __attribute__((ext_vector_type(4)));
typedef unsigned u32x4 __attribute__((ext_vector_type(4)));
typedef unsigned u32x2 __attribute__((ext_vector_type(2)));

__device__ __forceinline__ unsigned f2bf(float f) { unsigned u = __builtin_bit_cast(unsigned, f); return (u + 0x7fffu + ((u >> 16) & 1u)) >> 16; }
__device__ __forceinline__ unsigned pk2(float lo, float hi) { return f2bf(lo) | (f2bf(hi) << 16); }
__device__ __forceinline__ float bf2f(unsigned v) { return __builtin_bit_cast(float, v << 16); }
__device__ __forceinline__ float wave_sum(float v) {
#pragma unroll
    for (int o = 1; o < 64; o <<= 1) v += __shfl_xor(v, o);
    return v;
}
__device__ __forceinline__ float silu_f(float v) { return v / (1.f + __expf(-v)); }

struct EpiP {
    static constexpr bool PERM = true, AFTER_DRAIN = false;
    bf16* P; const float* bgate;
    __device__ __forceinline__ void operator()(const pg8::f32x4 (&acc)[2][2][4][2], const pg8::Unit& u, int wr, int wc, int fr, int fq) const {
        const int pn = u.pn;
        const int row0 = u.pm * 256 + wr * 64 + fr;
        const int cl = wc * 32 + 8 * fq;
        if (pn < 4) {
            const float sc = (pn >= 2) ? 0.08838834764831845f : 1.0f;
            float frev[4];
#pragma unroll
            for (int j = 0; j < 4; ++j) frev[j] = exp2f(-(float)(16 * wc + 4 * fq + j) * 0.20762050593046014f) * 0.15915494309189535f;
#pragma unroll
            for (int ai = 0; ai < 2; ++ai)
#pragma unroll
                for (int m = 0; m < 4; ++m) {
                    const int row = row0 + ai * 128 + m * 16;
                    const float pos = (float)(row & (SEQ - 1));
                    float sn[4], cs[4];
#pragma unroll
                    for (int j = 0; j < 4; ++j) { const float rev = __builtin_amdgcn_fractf(pos * frev[j]); sn[j] = __builtin_amdgcn_sinf(rev) * sc; cs[j] = __builtin_amdgcn_cosf(rev) * sc; }
#pragma unroll
                    for (int bj = 0; bj < 2; ++bj) {
                        const pg8::f32x4 v0 = acc[ai][bj][m][0], v1 = acc[ai][bj][m][1];
                        u32x4 w;
                        w.x = pk2(v0[0] * cs[0] - v0[1] * sn[0], v0[0] * sn[0] + v0[1] * cs[0]);
                        w.y = pk2(v0[2] * cs[1] - v0[3] * sn[1], v0[2] * sn[1] + v0[3] * cs[1]);
                        w.z = pk2(v1[0] * cs[2] - v1[1] * sn[2], v1[0] * sn[2] + v1[1] * cs[2]);
                        w.w = pk2(v1[2] * cs[3] - v1[3] * sn[3], v1[2] * sn[3] + v1[3] * cs[3]);
                        *(u32x4*)(P + (size_t)row * PW + pn * 256 + bj * 128 + cl) = w;
                    }
                }
        } else if (pn < 14) {
            const bool act = (pn == 6 || pn == 7 || pn == 12 || pn == 13);
            const float sc = (pn == 8) ? 0.125f : 1.0f;
#pragma unroll
            for (int ai = 0; ai < 2; ++ai)
#pragma unroll
                for (int m = 0; m < 4; ++m) {
                    const int row = row0 + ai * 128 + m * 16;
#pragma unroll
                    for (int bj = 0; bj < 2; ++bj) {
                        pg8::f32x4 v0 = acc[ai][bj][m][0] * sc, v1 = acc[ai][bj][m][1] * sc;
                        if (act) {
#pragma unroll
                            for (int i = 0; i < 4; ++i) { v0[i] = silu_f(v0[i]); v1[i] = silu_f(v1[i]); }
                        }
                        u32x4 w; w.x = pk2(v0[0], v0[1]); w.y = pk2(v0[2], v0[3]); w.z = pk2(v1[0], v1[1]); w.w = pk2(v1[2], v1[3]);
                        *(u32x4*)(P + (size_t)row * PW + pn * 256 + bj * 128 + cl) = w;
                    }
                }
        } else {
            pg8::f32x4 bv[2][2];
#pragma unroll
            for (int bj = 0; bj < 2; ++bj) { bv[bj][0] = *(const pg8::f32x4*)(bgate + bj * 128 + cl); bv[bj][1] = *(const pg8::f32x4*)(bgate + bj * 128 + cl + 4); }
#pragma unroll
            for (int ai = 0; ai < 2; ++ai)
#pragma unroll
                for (int m = 0; m < 4; ++m) {
                    const int row = row0 + ai * 128 + m * 16;
#pragma unroll
                    for (int bj = 0; bj < 2; ++bj) {
                        pg8::f32x4 v0 = acc[ai][bj][m][0] + bv[bj][0], v1 = acc[ai][bj][m][1] + bv[bj][1];
#pragma unroll
                        for (int i = 0; i < 4; ++i) { v0[i] = (fminf(v0[i], 0.f) - log1pf(__expf(-fabsf(v0[i])))) * (1.f / 16.f); v1[i] = (fminf(v1[i], 0.f) - log1pf(__expf(-fabsf(v1[i])))) * (1.f / 16.f); }
                        u32x4 w; w.x = pk2(v0[0], v0[1]); w.y = pk2(v0[2], v0[3]); w.z = pk2(v1[0], v1[1]); w.w = pk2(v1[2], v1[3]);
                        *(u32x4*)(P + (size_t)row * PW + pn * 256 + bj * 128 + cl) = w;
                    }
                }
        }
    }
};
struct EpiOut {
    static constexpr bool PERM = false, AFTER_DRAIN = false;
    const float* x; const float* gate; float* out;
    __device__ __forceinline__ void operator()(const pg8::f32x4 (&acc)[2][2][4][2], const pg8::Unit& u, int wr, int wc, int fr, int fq) const {
        const int row0 = u.pm * 256 + wr * 64 + fr, col0 = u.pn * 256 + wc * 32 + 4 * fq, b = u.pm >> 3;
        pg8::f32x4 g[2][2];
#pragma unroll
        for (int bj = 0; bj < 2; ++bj)
#pragma unroll
            for (int n = 0; n < 2; ++n) g[bj][n] = *(const pg8::f32x4*)(gate + b * DM + col0 + bj * 128 + n * 16);
#pragma unroll
        for (int ai = 0; ai < 2; ++ai)
#pragma unroll
            for (int m = 0; m < 4; ++m) {
                const size_t ro = (size_t)(row0 + ai * 128 + m * 16) * DM + col0;
#pragma unroll
                for (int bj = 0; bj < 2; ++bj)
#pragma unroll
                    for (int n = 0; n < 2; ++n) {
                        const size_t off = ro + bj * 128 + n * 16;
                        const pg8::f32x4 xv = *(const pg8::f32x4*)(x + off);
                        *(pg8::f32x4*)(out + off) = xv + g[bj][n] * acc[ai][bj][m][n];
                    }
            }
    }
};

__device__ __forceinline__ void phase_ada(LAS unsigned char* lds, const float* c, const float* w_ada, const float* b_ada, const float* norm_gain, float* MUL, float* SHIFT, float* GATE) {
    const int tid = threadIdx.x, lane = tid & 63, wave = tid >> 6;
    LAS float* sc = (LAS float*)lds;
    LAS float* red = (LAS float*)(lds + 131072);
    for (int i = tid; i < NB * DM; i += 512) sc[i] = silu_f(c[i]);
    __syncthreads();
    const int kg = tid >> 4, cs = tid & 15;
    for (int cb = blockIdx.x; cb < 256; cb += gridDim.x) {
        float acc[32];
#pragma unroll
        for (int b = 0; b < 32; ++b) acc[b] = 0.f;
        if (cs < 12) {
            const float* wp = w_ada + cb * 12 + cs;
            for (int k = kg; k < DM; k += 32) {
                const float w = wp[(size_t)k * 3072];
#pragma unroll
                for (int b = 0; b < 32; ++b) acc[b] += sc[b * 1024 + k] * w;
            }
        }
#pragma unroll
        for (int b = 0; b < 32; ++b) { acc[b] += __shfl_xor(acc[b], 16); acc[b] += __shfl_xor(acc[b], 32); }
        if (lane < 16) {
#pragma unroll
            for (int b = 0; b < 32; ++b) red[(wave * 16 + cs) * 32 + b] = acc[b];
        }
        __syncthreads();
        if (tid < 384) {
            const int cs2 = tid >> 5, b = tid & 31; float v = 0.f;
#pragma unroll
            for (int w = 0; w < 8; ++w) v += red[(w * 16 + cs2) * 32 + b];
            const int n = cb * 12 + cs2; v += b_ada[n];
            if (n < 1024) SHIFT[b * 1024 + n] = v;
            else if (n < 2048) MUL[b * 1024 + n - 1024] = norm_gain[n - 1024] * (1.f + v);
            else GATE[b * 1024 + n - 2048] = v;
        }
        __syncthreads();
    }
}

__device__ __forceinline__ int src_col(int n) {
    if (n >= 3584) return -2;
    if (n < 1024) { const int pc = n & 127; return (n & ~127) + (pc >> 1) + ((pc & 1) << 6); }
    return n;
}
__device__ __forceinline__ void transpose_item(const float* W, int N, bool permute, const float* Wg, bf16* WT, LAS float* scr, int item, int nblk, int lane) {
    const int kb = item / nblk, nb = item % nblk, k0 = 64 * kb, n0 = 32 * nb;
    const int src = permute ? src_col(n0 + (lane & 31)) : n0 + (lane & 31);
    if (src == -2) {
        float wg[16];
#pragma unroll
        for (int r = 0; r < 16; ++r) wg[r] = Wg[r * 256 + n0 + (lane & 31) - 3584];
        for (int i = 0; i < 32; ++i) { const int kk = 2 * i + (lane >> 5); const float* wr = W + (size_t)(k0 + kk) * N + 3584; float v = 0.f;
#pragma unroll
            for (int r = 0; r < 16; ++r) v += wr[r] * wg[r];
            scr[kk * 33 + (lane & 31)] = v; }
    } else {
#pragma unroll 8
        for (int i = 0; i < 32; ++i) { const int kk = 2 * i + (lane >> 5); scr[kk * 33 + (lane & 31)] = (src >= 0) ? W[(size_t)(k0 + kk) * N + src] : 0.f; }
    }
    asm volatile("s_waitcnt lgkmcnt(0)" ::: "memory");
    const int c = lane & 7;
#pragma unroll
    for (int j = 0; j < 4; ++j) {
        const int n = (lane >> 3) + 8 * j; const LAS float* s = scr + (8 * c) * 33 + n;
        u32x4 o; o.x = pk2(s[0 * 33], s[1 * 33]); o.y = pk2(s[2 * 33], s[3 * 33]); o.z = pk2(s[4 * 33], s[5 * 33]); o.w = pk2(s[6 * 33], s[7 * 33]);
        *(u32x4*)(WT + (size_t)(n0 + n) * 1024 + k0 + 8 * c) = o;
    }
    asm volatile("s_waitcnt lgkmcnt(0)" ::: "memory");
}
__device__ __forceinline__ void phase_prep(LAS unsigned char* lds, const float* x, const float* w_in, const float* w_out, const float* w_gate, const float* MUL, const float* SHIFT, bf16* WIN, bf16* WOUT, bf16* H) {
    const int tid = threadIdx.x, lane = tid & 63, wave = tid >> 6;
    LAS float* scr = (LAS float*)(lds + wave * 16384);
    const int gw = blockIdx.x * 8 + wave, NGW = gridDim.x * 8;
    constexpr int I_IN = 16 * (NPAD / 32), I_OUT = 16 * (DM / 32);
    for (int it = gw; it < I_IN + I_OUT; it += NGW) {
        if (it < I_IN) transpose_item(w_in, DIN, true, w_gate, WIN, scr, it, NPAD / 32, lane);
        else transpose_item(w_out, DM, false, w_gate, WOUT, scr, it - I_IN, DM / 32, lane);
    }
    for (int m = gw; m < NT; m += NGW) {
        const f32x4* xr = (const f32x4*)(x + (size_t)m * DM) + lane;
        f32x4 v[4]; float ss = 0.f;
#pragma unroll
        for (int j = 0; j < 4; ++j) { v[j] = xr[64 * j]; ss += (v[j].x * v[j].x + v[j].y * v[j].y) + (v[j].z * v[j].z + v[j].w * v[j].w); }
        ss = wave_sum(ss);
        const float r = 1.0f / sqrtf(ss * (1.f / DM) + EPS);
        const int b = m >> 11;
        const f32x4* mr = (const f32x4*)(MUL + b * DM) + lane; const f32x4* sr = (const f32x4*)(SHIFT + b * DM) + lane;
        unsigned long long* o8 = (unsigned long long*)(H + (size_t)m * DM) + lane;
#pragma unroll
        for (int j = 0; j < 4; ++j) {
            const f32x4 hv = v[j] * r * mr[64 * j] + sr[64 * j];
            o8[64 * j] = (unsigned long long)pk2(hv.x, hv.y) | ((unsigned long long)pk2(hv.z, hv.w) << 32);
        }
    }
}

#ifndef STREAM_MFMA
#define STREAM_MFMA 2
#endif
typedef short bf16x8 __attribute__((ext_vector_type(8)));
typedef float f32x16 __attribute__((ext_vector_type(16)));
#define MFMA16(a, b, c) __builtin_amdgcn_mfma_f32_16x16x32_bf16((a), (b), (c), 0, 0, 0)
#define MFMA32(a, b, c) __builtin_amdgcn_mfma_f32_32x32x16_bf16((a), (b), (c), 0, 0, 0)
__device__ __forceinline__ void unpack8(const u32x4 p, float (&f)[8]) {
    f[0] = bf2f(p.x & 0xffffu); f[1] = bf2f(p.x >> 16); f[2] = bf2f(p.y & 0xffffu); f[3] = bf2f(p.y >> 16);
    f[4] = bf2f(p.z & 0xffffu); f[5] = bf2f(p.z >> 16); f[6] = bf2f(p.w & 0xffffu); f[7] = bf2f(p.w >> 16);
}
__device__ __forceinline__ u32x4 pack8(const float (&f)[8]) { u32x4 o; o.x = pk2(f[0], f[1]); o.y = pk2(f[2], f[3]); o.z = pk2(f[4], f[5]); o.w = pk2(f[6], f[7]); return o; }

typedef short s16x4 __attribute__((ext_vector_type(4)));
__device__ __forceinline__ bf16x8 tr_frag(const LAS unsigned char* p, int off, int rsb) {
    const s16x4 lo = __builtin_amdgcn_ds_read_tr16_b64_v4i16((LAS s16x4*)(p + off));
    const s16x4 hi = __builtin_amdgcn_ds_read_tr16_b64_v4i16((LAS s16x4*)(p + off + 4 * rsb));
    return __builtin_shufflevector(lo, hi, 0, 1, 2, 3, 4, 5, 6, 7);
}
template <int DK, bool GLA>
__device__ __forceinline__ void stream_mfma(LAS unsigned char* lds, const bf16* P, const float* gng, bf16* MIX, int b, int h) {
    constexpr int QS = DK + 8, JS = 72, NQ = DK / 64, NR = DK / 64, KS = DK / 16, YS = 132;
    constexpr int RSB = 320;
    constexpr int SZ_Q = 64 * QS * 2, SZ_KHT = 64 * RSB;
    constexpr int SZ_KK = (SZ_Q + SZ_KHT) > 64 * YS * 4 ? (SZ_Q + SZ_KHT) : 64 * YS * 4;
    constexpr int O_QT = 0, O_KT = SZ_Q, O_KHT = O_KT + SZ_Q, O_YB = O_KT, O_VT = O_KT + SZ_KK, O_ST = O_VT + 64 * RSB, O_RT = O_ST + 64 * JS * 2;
    constexpr int O_BT = O_RT + 128 * QS * 2, O_TOT = O_BT + (GLA ? 32768 : 0), O_END = O_TOT + (GLA ? 4096 : 0);
    static_assert(O_END <= LDS_MISC, "stream LDS map");
    LAS bf16* Qt = (LAS bf16*)(lds + O_QT); LAS bf16* Kt = (LAS bf16*)(lds + O_KT); LAS unsigned char* Kh = lds + O_KHT;
    LAS unsigned char* Vr = lds + O_VT; LAS bf16* St = (LAS bf16*)(lds + O_ST); LAS bf16* RT = (LAS bf16*)(lds + O_RT);
    LAS float* Yb = (LAS float*)(lds + O_YB); LAS float* BT = (LAS float*)(lds + O_BT); LAS float* TOT = (LAS float*)(lds + O_TOT);

    const int tid = threadIdx.x, lane = tid & 63, w = __builtin_amdgcn_readfirstlane(tid >> 6);
    const int l31 = lane & 31, hh = lane >> 5, l15 = lane & 15, q4 = lane >> 4;
    const int qcol = GLA ? 2048 + 64 * h : 128 * h, kcol = GLA ? 2304 + 64 * h : 512 + 128 * h;
    const int vcol = GLA ? 2560 + 128 * h : 1024 + 128 * h, zcol = GLA ? 3072 + 128 * h : 1536 + 128 * h, ocol = GLA ? 512 + 128 * h : 128 * h;
    const int trb = (8 * hh + (l15 >> 2)) * RSB + (16 * (q4 & 1) + 4 * (lane & 3)) * 2;
    const float lg2g = log2f(1.f - exp2f(-5.f - (float)h));
    const bf16* Pb = P + (size_t)b * SEQ * PW;
    const int qrow = GLA ? (tid >> 3) : (tid >> 4), qc8 = GLA ? (tid & 7) : (tid & 15);
    const int vrow = tid >> 4, vc8 = tid & 15;
    const int zi = tid >> 3, zseg = tid & 7;
    bf16 lgr[8];
    u32x4 pq[NQ], pk[NQ], pv[2], pz[2], zc[2];
    float la[8];
#define STREAM_LOAD(n) do { const bf16* base_ = Pb + (size_t)(n) * 64 * PW; \
        _Pragma("unroll") for (int i_ = 0; i_ < NQ; ++i_) { pq[i_] = *(const u32x4*)(base_ + (size_t)(qrow + 32 * i_) * PW + qcol + 8 * qc8); pk[i_] = *(const u32x4*)(base_ + (size_t)(qrow + 32 * i_) * PW + kcol + 8 * qc8); } \
        _Pragma("unroll") for (int i_ = 0; i_ < 2; ++i_) { pv[i_] = *(const u32x4*)(base_ + (size_t)(vrow + 32 * i_) * PW + vcol + 8 * vc8); pz[i_] = *(const u32x4*)(base_ + (size_t)zi * PW + zcol + 16 * zseg + 8 * i_); } \
        if (GLA) { _Pragma("unroll") for (int t_ = 0; t_ < 8; ++t_) lgr[t_] = base_[(size_t)(8 * w + t_) * PW + 3584 + 64 * h + lane]; } } while (0)
#define GATE_PART1(n) do { float run_ = 0.f; \
        _Pragma("unroll") for (int t_ = 0; t_ < 8; ++t_) { run_ += bf2f(lgr[t_]); la[t_] = run_; } \
        TOT[(((n) & 1) * 8 + w) * 64 + lane] = run_; } while (0)
#define GATE_PART2(n) do { float base_ = 0.f; for (int w_ = 0; w_ < w; ++w_) base_ += TOT[(((n) & 1) * 8 + w_) * 64 + lane]; \
        _Pragma("unroll") for (int t_ = 0; t_ < 8; ++t_) BT[((n) & 1) * 4096 + (8 * w + t_) * 64 + lane] = base_ + la[t_]; } while (0)

    __syncthreads();
    STREAM_LOAD(0);
    if (GLA) { GATE_PART1(0); __syncthreads(); GATE_PART2(0); }
    f32x16 R[NR];
#pragma unroll
    for (int t = 0; t < NR; ++t)
#pragma unroll
        for (int i = 0; i < 16; ++i) R[t][i] = 0.f;
    const int eb = w & 3;

    for (int n = 0; n < SEQ / 64; ++n) {
        __syncthreads();
        const LAS float* BTc = BT + (n & 1) * 4096;
#pragma unroll
        for (int i = 0; i < NQ; ++i) {
            const int row = qrow + 32 * i;
            float fq[8], fk[8], fh[8];
            unpack8(pq[i], fq); unpack8(pk[i], fk);
            if (GLA) {
                const f32x4 b0 = *(const LAS f32x4*)(BTc + row * 64 + 8 * qc8), b1 = *(const LAS f32x4*)(BTc + row * 64 + 8 * qc8 + 4);
                const f32x4 e0 = *(const LAS f32x4*)(BTc + 63 * 64 + 8 * qc8), e1 = *(const LAS f32x4*)(BTc + 63 * 64 + 8 * qc8 + 4);
#pragma unroll
                for (int e = 0; e < 8; ++e) { const float bb = e < 4 ? b0[e & 3] : b1[e & 3], bl = e < 4 ? e0[e & 3] : e1[e & 3];
                    fq[e] *= __expf(bb); fh[e] = fk[e] * __expf(bl - bb); fk[e] *= __expf(-bb); }
            } else {
                const float sq = exp2f((float)(row + 1) * lg2g), sk = exp2f(-(float)(row + 1) * lg2g), sh = exp2f((float)(63 - row) * lg2g);
#pragma unroll
                for (int e = 0; e < 8; ++e) { fq[e] *= sq; fh[e] = fk[e] * sh; fk[e] *= sk; }
            }
            *(LAS u32x4*)(Qt + row * QS + 8 * qc8) = pack8(fq);
            *(LAS u32x4*)(Kt + row * QS + 8 * qc8) = pack8(fk);
            *(LAS u32x4*)(Kh + row * RSB + 16 * qc8) = pack8(fh);
        }
#pragma unroll
        for (int i = 0; i < 2; ++i) {
            *(LAS u32x4*)(Vr + (vrow + 32 * i) * RSB + 16 * vc8) = pv[i];
        }
        zc[0] = pz[0]; zc[1] = pz[1];
#pragma unroll
        for (int t = 0; t < NR; ++t) {
            const int db = NR * (w >> 2) + t;
#pragma unroll
            for (int g = 0; g < 4; ++g) { u32x2 wv; wv.x = pk2(R[t][4 * g], R[t][4 * g + 1]); wv.y = pk2(R[t][4 * g + 2], R[t][4 * g + 3]);
                *(LAS u32x2*)(RT + (32 * eb + l31) * QS + 32 * db + 8 * g + 4 * hh) = wv; }
        }
        if (n + 1 < SEQ / 64) STREAM_LOAD(n + 1);
        __syncthreads();
        {
            const int ib = w & 3, jb0 = 2 * (w >> 2);
            pg8::f32x4 sacc[2] = {{0.f, 0.f, 0.f, 0.f}, {0.f, 0.f, 0.f, 0.f}};
#pragma unroll
            for (int s = 0; s < DK / 32; ++s) {
                const bf16x8 bq = *(const LAS bf16x8*)(Qt + (16 * ib + l15) * QS + 32 * s + 8 * q4);
#pragma unroll
                for (int t = 0; t < 2; ++t) { const bf16x8 ak = *(const LAS bf16x8*)(Kt + (16 * (jb0 + t) + l15) * QS + 32 * s + 8 * q4); sacc[t] = MFMA16(ak, bq, sacc[t]); }
            }
#pragma unroll
            for (int t = 0; t < 2; ++t) {
                const int i = 16 * ib + l15, j0 = 16 * (jb0 + t) + 4 * q4;
                u32x2 wv; wv.x = pk2(j0 <= i ? sacc[t][0] : 0.f, j0 + 1 <= i ? sacc[t][1] : 0.f); wv.y = pk2(j0 + 2 <= i ? sacc[t][2] : 0.f, j0 + 3 <= i ? sacc[t][3] : 0.f);
                *(LAS u32x2*)(St + i * JS + j0) = wv;
            }
        }
        bf16x8 vfrag[4];
#pragma unroll
        for (int s = 0; s < 4; ++s) vfrag[s] = tr_frag(Vr + trb + 64 * eb, 16 * s * RSB, RSB);
#pragma unroll
        for (int t = 0; t < NR; ++t) {
            const int db = NR * (w >> 2) + t;
            if (GLA) {
#pragma unroll
                for (int r = 0; r < 16; ++r) R[t][r] *= __expf(BTc[63 * 64 + 32 * db + (r & 3) + 8 * (r >> 2) + 4 * hh]);
            } else {
                const float a64 = exp2f(64.f * lg2g);
#pragma unroll
                for (int r = 0; r < 16; ++r) R[t][r] *= a64;
            }
#pragma unroll
            for (int s = 0; s < 4; ++s) R[t] = MFMA32(tr_frag(Kh + trb + 64 * db, 16 * s * RSB, RSB), vfrag[s], R[t]);
        }
        if (GLA) { if (n + 1 < SEQ / 64) GATE_PART1(n + 1); }
        __syncthreads();
        {
            const int ib = w >> 2;
            f32x16 y;
#pragma unroll
            for (int i = 0; i < 16; ++i) y[i] = 0.f;
#pragma unroll
            for (int s = 0; s < KS; ++s) {
                const bf16x8 a = *(const LAS bf16x8*)(RT + (32 * eb + l31) * QS + 16 * s + 8 * hh);
                const bf16x8 bq = *(const LAS bf16x8*)(Qt + (32 * ib + l31) * QS + 16 * s + 8 * hh);
                y = MFMA32(a, bq, y);
            }
#pragma unroll
            for (int s = 0; s < 4; ++s) {
                const bf16x8 bs = *(const LAS bf16x8*)(St + (32 * ib + l31) * JS + 16 * s + 8 * hh);
                y = MFMA32(vfrag[s], bs, y);
            }
#pragma unroll
            for (int g = 0; g < 4; ++g) { pg8::f32x4 o = {y[4 * g], y[4 * g + 1], y[4 * g + 2], y[4 * g + 3]}; *(LAS pg8::f32x4*)(Yb + (32 * ib + l31) * YS + 32 * eb + 8 * g + 4 * hh) = o; }
        }
        if (GLA) { if (n + 1 < SEQ / 64) GATE_PART2(n + 1); }
        __syncthreads();
        {
            float yv[16]; float ss = 0.f;
#pragma unroll
            for (int k = 0; k < 4; ++k) { const pg8::f32x4 t = *(const LAS pg8::f32x4*)(Yb + zi * YS + 16 * zseg + 4 * k); yv[4 * k] = t[0]; yv[4 * k + 1] = t[1]; yv[4 * k + 2] = t[2]; yv[4 * k + 3] = t[3]; ss += (t[0] * t[0] + t[1] * t[1]) + (t[2] * t[2] + t[3] * t[3]); }
            ss += __shfl_xor(ss, 1); ss += __shfl_xor(ss, 2); ss += __shfl_xor(ss, 4);
            const float r = 1.0f / sqrtf(ss * (1.f / 128.f) + EPS);
            float z0[8], z1[8]; unpack8(zc[0], z0); unpack8(zc[1], z1);
            float o0[8], o1[8];
#pragma unroll
            for (int e = 0; e < 8; ++e) {
                float g0 = r, g1 = r;
                if (GLA) { g0 *= gng[16 * zseg + e]; g1 *= gng[16 * zseg + 8 + e]; }
                o0[e] = yv[e] * g0 * z0[e]; o1[e] = yv[8 + e] * g1 * z1[e];
            }
            bf16* op = MIX + ((size_t)b * SEQ + 64 * n + zi) * DM + ocol + 16 * zseg;
            *(u32x4*)op = pack8(o0); *(u32x4*)(op + 8) = pack8(o1);
        }
    }
#undef STREAM_LOAD
#undef GATE_PART1
#undef GATE_PART2
}

__device__ __forceinline__ void phase_final(float* out, const float* final_gain) {
    const int tid = threadIdx.x, lane = tid & 63, wave = tid >> 6;
    const int gw = blockIdx.x * 8 + wave, NGW = gridDim.x * 8;
    f32x4 g[4];
#pragma unroll
    for (int j = 0; j < 4; ++j) g[j] = ((const f32x4*)final_gain)[lane + 64 * j];
    for (int m = gw; m < NT; m += NGW) {
        f32x4* xr = (f32x4*)(out + (size_t)m * DM) + lane;
        f32x4 v[4]; float ss = 0.f;
#pragma unroll
        for (int j = 0; j < 4; ++j) { v[j] = xr[64 * j]; ss += (v[j].x * v[j].x + v[j].y * v[j].y) + (v[j].z * v[j].z + v[j].w * v[j].w); }
        ss = wave_sum(ss);
        const float r = 1.0f / sqrtf(ss * (1.f / DM) + EPS);
#pragma unroll
        for (int j = 0; j < 4; ++j) xr[64 * j] = v[j] * r * g[j];
    }
}

#define XB_TMO      128
#define XB_XCNT(j)  (256  + 64 * (j))
#define XB_XSUB(j)  (1280 + 64 * (j))
#define XB_XGEN(j)  (2304 + 64 * (j))
#define XB_TOP      3328
#define XB_TOPGEN   3392
#define XCD_BAR_WORDS 3456
#define XB_SPIN_CAP (1u << 18)

__device__ __forceinline__ unsigned xb_ld(unsigned* p)              { return __hip_atomic_load(p, __ATOMIC_RELAXED, __HIP_MEMORY_SCOPE_AGENT); }
__device__ __forceinline__ unsigned xb_add(unsigned* p, unsigned v) { return __hip_atomic_fetch_add(p, v, __ATOMIC_RELAXED, __HIP_MEMORY_SCOPE_AGENT); }
__device__ __forceinline__ unsigned xb_xcc_id() { return (unsigned)__builtin_amdgcn_s_getreg((3 << 11) | 20) & 0xFu; }
#define XB_SPIN(cond, bar) do { unsigned _sp = 0; while (cond) { __builtin_amdgcn_s_sleep(1); \
    if ((++_sp & 255u) == 0u) { if (xb_ld(&(bar)[XB_TMO])) break; if (_sp > XB_SPIN_CAP) { atomicAdd(&(bar)[XB_TMO], 1u); break; } } } } while (0)

struct XcdBarrier {
    unsigned* bar; unsigned x;
    volatile LAS unsigned* st;
};

__device__ __forceinline__ XcdBarrier xcd_barrier_post(unsigned* bar, volatile LAS unsigned* st) {
    XcdBarrier b; b.bar = bar; b.x = xb_xcc_id(); b.st = st;
    if (threadIdx.x == 0) (void)xb_add(&bar[XB_XCNT(b.x)], 1u);
    return b;
}
__device__ __forceinline__ void xcd_barrier_complete(unsigned* bar, unsigned x, unsigned& nloc, unsigned& nx) {
    const unsigned G = gridDim.x * gridDim.y * gridDim.z;
    unsigned sum, cnt, mine, sp = 0u;
    for (;;) {
        sum = 0u; cnt = 0u; mine = 0u;
#pragma unroll
        for (unsigned j = 0; j < 16; ++j) { const unsigned c = xb_ld(&bar[XB_XCNT(j)]); sum += c; cnt += (c > 0u) ? 1u : 0u; mine = (j == x) ? c : mine; }
        if (sum == G) break;
        __builtin_amdgcn_s_sleep(1);
        if ((++sp & 255u) == 0u) { if (xb_ld(&bar[XB_TMO])) break; if (sp > XB_SPIN_CAP) { atomicAdd(&bar[XB_TMO], 1u); break; } }
    }
    nloc = mine > 0u ? mine : 1u; nx = cnt > 0u ? cnt : 1u;
}

__device__ __forceinline__ void xcd_barrier(const XcdBarrier& b) {
    asm volatile("s_waitcnt vmcnt(0)" ::: "memory");
    __syncthreads();
    if (threadIdx.x == 0) {
        unsigned* bar = b.bar;
        __builtin_amdgcn_s_waitcnt(0);
        unsigned nloc = b.st[0], nx = b.st[1];
        if (nloc == 0u) { xcd_barrier_complete(bar, b.x, nloc, nx); b.st[0] = nloc; b.st[1] = nx; }
        const unsigned old = xb_add(&bar[XB_XSUB(b.x)], 1u);
        const unsigned gen = old / nloc;
        if (old + 1u == (gen + 1u) * nloc) {
            __builtin_amdgcn_fence(__ATOMIC_RELEASE, "agent");
            asm volatile("s_waitcnt vmcnt(0)" ::: "memory");
            const unsigned og = xb_add(&bar[XB_TOP], 1u);
            const unsigned tg = og / nx;
            if (og + 1u == (tg + 1u) * nx) xb_add(&bar[XB_TOPGEN], 1u);
            else XB_SPIN(xb_ld(&bar[XB_TOPGEN]) == tg, bar);
            __builtin_amdgcn_fence(__ATOMIC_ACQUIRE, "agent");
            xb_add(&bar[XB_XGEN(b.x)], 1u);
            asm volatile("s_waitcnt vmcnt(0)" ::: "memory");
        } else {
            XB_SPIN(xb_ld(&bar[XB_XGEN(b.x)]) == gen, bar);
            __builtin_amdgcn_fence(__ATOMIC_ACQUIRE, "agent");
            asm volatile("s_waitcnt vmcnt(0)" ::: "memory");
        }
    }
    __syncthreads();
}

struct Args { const float* in[11]; float* out; unsigned char* ws; int ph_lo, ph_hi; };
#ifndef ONE_LAUNCH
#define ONE_LAUNCH 1
#endif
constexpr int N_PHASES = 6;
#ifndef REP2
#define REP2 1
#endif
#ifndef REP3
#define REP3 1
#endif
#ifndef REP4
#define REP4 1
#endif

template <bool COOP>
__global__ void __launch_bounds__(512, 2) fwd(Args a) {
    extern __shared__ __attribute__((aligned(16))) unsigned char lds_raw[];
    LAS unsigned char* lds = (LAS unsigned char*)lds_raw;
    const float* x = a.in[0]; const float* c = a.in[1]; const float* norm_gain = a.in[2]; const float* w_ada = a.in[3]; const float* b_ada = a.in[4];
    const float* w_in = a.in[5]; const float* w_gate = a.in[6]; const float* b_gate = a.in[7]; const float* gng = a.in[8]; const float* w_out = a.in[9]; const float* final_gain = a.in[10];
    unsigned char* ws = a.ws;
    float* MUL = (float*)(ws + WS_MUL); float* SHIFT = (float*)(ws + WS_SHIFT); float* GATE = (float*)(ws + WS_GATE);
    bf16* WIN = (bf16*)(ws + WS_WIN); bf16* WOUT = (bf16*)(ws + WS_WOUT);
    bf16* H = (bf16*)(ws + WS_H); bf16* P = (bf16*)(ws + WS_P); bf16* MIX = (bf16*)(ws + WS_MIX);
    const int lo = a.ph_lo, hi = a.ph_hi;
    XcdBarrier bar; bar.bar = (unsigned*)(ws + WS_CTL); bar.x = 0; bar.st = nullptr;
    if (COOP) {
        volatile LAS unsigned* misc = (volatile LAS unsigned*)(lds + LDS_MISC);
        if (threadIdx.x < 2) misc[threadIdx.x] = 0u;
        __syncthreads();
        bar = xcd_barrier_post((unsigned*)(ws + WS_CTL), misc);
    }
#define IN(k) (lo <= (k) && (k) < hi)
#define GRIDSYNC() xcd_barrier(bar)
#define SEAM(k) do { if (COOP) { if (IN(k) && IN((k) + 1)) GRIDSYNC(); } } while (0)
    if (IN(0)) phase_ada(lds, c, w_ada, b_ada, norm_gain, MUL, SHIFT, GATE);
    SEAM(0);
    if (IN(1)) phase_prep(lds, x, w_in, w_out, w_gate, MUL, SHIFT, WIN, WOUT, H);
    SEAM(1);
#define PH2 \
    if (IN(2)) { \
        pg8::Gemm g{H, WIN, NT, NPAD, DM}; pg8::StaticOrder S; S.init(NT, NPAD, (int)gridDim.x, (int)blockIdx.x); \
        EpiP E{P, b_gate}; \
        pg8::gemm_phase<EpiP, pg8::StaticOrder, true, true>(lds, g, S, E); \
    }
    PH2
    if (REP2 > 1) { if (COOP) GRIDSYNC(); PH2 }
    SEAM(2);
    for (int rep = 0; rep < REP3; ++rep) { if (rep) { if (COOP) GRIDSYNC(); }
    if (IN(3)) {
        for (int s = blockIdx.x; s < 256; s += gridDim.x) {
            const int bh = s >> 1, b = bh >> 2, h = bh & 3;
            if (s & 1) stream_mfma<64, true>(lds, P, gng, MIX, b, h);
            else stream_mfma<128, false>(lds, P, gng, MIX, b, h);
        }
    } }
    SEAM(3);
#define PH4 \
    if (IN(4)) { \
        pg8::Gemm g{MIX, WOUT, NT, DM, DM}; pg8::StaticOrder S; S.init(NT, DM, (int)gridDim.x, (int)blockIdx.x); \
        EpiOut E{x, GATE, a.out}; \
        pg8::gemm_phase<EpiOut, pg8::StaticOrder, true, true>(lds, g, S, E); \
    }
    PH4
    if (REP4 > 1) { if (COOP) GRIDSYNC(); PH4 }
    SEAM(4);
    if (IN(5)) phase_final(a.out, final_gain);
#undef IN
#undef SEAM
}

extern "C" void kernel_launch(void* const* d_in, const int* in_sizes, int n_in, void* d_out, int out_size, void* d_ws, size_t ws_size, hipStream_t stream) {
    static int grid = 0;
    if (grid == 0) {
        if (n_in != 11 || in_sizes[0] != NT * DM || out_size != NT * DM || ws_size < WS_END) { fprintf(stderr, "kernel_launch: unexpected shapes (n_in %d, in0 %d, out %d, ws %zu)\n", n_in, n_in > 0 ? in_sizes[0] : -1, out_size, ws_size); grid = -1; return; }
        int dev = 0, cus = 0, per_cu = 0;
        if (hipGetDevice(&dev) != hipSuccess || hipDeviceGetAttribute(&cus, hipDeviceAttributeMultiprocessorCount, dev) != hipSuccess) { grid = -1; return; }
        (void)hipFuncSetAttribute((const void*)fwd<true>, hipFuncAttributeMaxDynamicSharedMemorySize, LDS_BYTES);
        (void)hipFuncSetAttribute((const void*)fwd<false>, hipFuncAttributeMaxDynamicSharedMemorySize, LDS_BYTES);
        if (hipOccupancyMaxActiveBlocksPerMultiprocessor(&per_cu, (const void*)fwd<true>, 512, LDS_BYTES) != hipSuccess || per_cu < 1) { fprintf(stderr, "kernel_launch: occupancy query says %d blocks per CU; nothing launched\n", per_cu); grid = -1; return; }
        (void)hipGetLastError();
        grid = cus;
    }
    if (grid < 0) return;
    Args a{};
    for (int i = 0; i < 11; ++i) a.in[i] = (const float*)d_in[i];
    a.out = (float*)d_out; a.ws = (unsigned char*)d_ws;
#if ONE_LAUNCH
    a.ph_lo = 0; a.ph_hi = N_PHASES;
    if (hipMemsetAsync((char*)d_ws + WS_CTL, 0, CTL_BYTES, stream) != hipSuccess) { fprintf(stderr, "kernel_launch: memset of the barrier words failed\n"); return; }
    hipLaunchKernelGGL(fwd<true>, dim3(grid), dim3(512), LDS_BYTES, stream, a);
#else
    for (int p = 0; p < N_PHASES; ++p) {
        a.ph_lo = p; a.ph_hi = p + 1;
        hipLaunchKernelGGL(fwd<false>, dim3(grid), dim3(512), LDS_BYTES, stream, a);
    }
#endif
}
```
